# Optimizing an MI355X kernel written in HIP

```python
import math
import jax, jax.numpy as jnp
from jax import lax
import numpy as np

D_MODEL = 1024
BATCH = 16
SEQ = 2048
DEPTH = 1

HEAD_DIM = 64
DIFF_WIDTH = D_MODEL // 2
N_DIFF_HEADS = DIFF_WIDTH // (2 * HEAD_DIM)
SB_WIDTH = D_MODEL - DIFF_WIDTH
N_SB_HEADS = SB_WIDTH // HEAD_DIM
MIX_WIDTH = DIFF_WIDTH + SB_WIDTH
D_FF = 4 * D_MODEL
Q_BLOCK = 128
EPS = 1e-6
LAMBDA_STD = 0.1

kernel_name = "hymba_diffattn_stickbreaking_sqrelu"


def rmsnorm(x, gain):
    xf = x.astype(jnp.float32)
    inv = lax.rsqrt(jnp.mean(xf * xf, axis=-1, keepdims=True) + EPS)
    return (xf * inv * gain.astype(jnp.float32)).astype(x.dtype)


def lambda_init_fn(layer_idx):
    return 0.8 - 0.6 * math.exp(-0.3 * layer_idx)


def alibi_slopes(n_heads):
    return jnp.asarray([2.0 ** (-8.0 * (h + 1) / n_heads) for h in range(n_heads)], dtype=jnp.float32)


def diff_attn_block(q1, q2, k1, k2, v, lam, slopes, q0):
    tq, tk = q1.shape[2], k1.shape[2]
    qpos = q0 + jnp.arange(tq)
    kpos = jnp.arange(tk)
    dist = (qpos[:, None] - kpos[None, :]).astype(jnp.float32)
    causal = dist >= 0
    bias = -slopes[:, None, None] * dist
    scale = 1.0 / math.sqrt(HEAD_DIM)

    def probs(q, k):
        s = jnp.einsum('bhqd,bhkd->bhqk', q, k).astype(jnp.float32) * scale + bias
        s = jnp.where(causal, s, -jnp.inf)
        return jax.nn.softmax(s, axis=-1)

    a = probs(q1, k1) - lam * probs(q2, k2)
    return jnp.einsum('bhqk,bhkd->bhqd', a.astype(v.dtype), v)


def stick_breaking_block(q, k, v, q0):
    tq, tk = q.shape[2], k.shape[2]
    qpos = q0 + jnp.arange(tq)
    kpos = jnp.arange(tk)
    strict = kpos[None, :] < qpos[:, None]
    z = jnp.einsum('bhqd,bhkd->bhqk', q, k).astype(jnp.float32) * (1.0 / math.sqrt(HEAD_DIM))
    log_beta = jax.nn.log_sigmoid(z)
    log_om = jnp.where(strict, jax.nn.log_sigmoid(-z), 0.0)
    later = lax.cumsum(log_om, axis=3, reverse=True) - log_om
    w = jnp.where(strict, jnp.exp(log_beta + later), 0.0)
    return jnp.einsum('bhqk,bhkd->bhqd', w.astype(v.dtype), v)


def to_heads(t, n_heads, dim):
    b, s, _ = t.shape
    return t.reshape(b, s, n_heads, dim).transpose(0, 2, 1, 3)


def hybrid_mixer(h, w_in, lq1, lk1, lq2, lk2, diff_g, sb_g, w_out, layer_idx):
    b, s, _ = h.shape
    proj = jnp.einsum('bsd,de->bse', h, w_in)
    dq, dk, dv, sq, sk, sv = jnp.split(
        proj, np.cumsum([DIFF_WIDTH, DIFF_WIDTH, DIFF_WIDTH, SB_WIDTH, SB_WIDTH])[:].tolist(), axis=-1)
    dq = to_heads(dq, 2 * N_DIFF_HEADS, HEAD_DIM)
    dk = to_heads(dk, 2 * N_DIFF_HEADS, HEAD_DIM)
    q1, q2 = dq[:, 0::2], dq[:, 1::2]
    k1, k2 = dk[:, 0::2], dk[:, 1::2]
    dv = to_heads(dv, N_DIFF_HEADS, 2 * HEAD_DIM)
    sq = to_heads(sq, N_SB_HEADS, HEAD_DIM)
    sk = to_heads(sk, N_SB_HEADS, HEAD_DIM)
    sv = to_heads(sv, N_SB_HEADS, HEAD_DIM)

    lam_init = lambda_init_fn(layer_idx)
    lam = (jnp.exp(jnp.sum(lq1.astype(jnp.float32) * lk1.astype(jnp.float32)))
           - jnp.exp(jnp.sum(lq2.astype(jnp.float32) * lk2.astype(jnp.float32)))
           + lam_init)
    slopes = alibi_slopes(N_DIFF_HEADS)

    diff_out, sb_out = [], []
    for i in range(s // Q_BLOCK):
        q0 = i * Q_BLOCK
        qe = q0 + Q_BLOCK
        diff_out.append(diff_attn_block(q1[:, :, q0:qe], q2[:, :, q0:qe], k1[:, :, :qe], k2[:, :, :qe],
                                        dv[:, :, :qe], lam, slopes, q0))
        sb_out.append(stick_breaking_block(sq[:, :, q0:qe], sk[:, :, :qe], sv[:, :, :qe], q0))
    diff_o = jnp.concatenate(diff_out, axis=2)
    sb_o = jnp.concatenate(sb_out, axis=2)

    diff_o = rmsnorm(diff_o, diff_g) * (1.0 - lam_init)
    sb_o = rmsnorm(sb_o, sb_g)
    diff_o = diff_o.transpose(0, 2, 1, 3).reshape(b, s, DIFF_WIDTH)
    sb_o = sb_o.transpose(0, 2, 1, 3).reshape(b, s, SB_WIDTH)
    mixed = jnp.concatenate([diff_o, sb_o], axis=-1)
    return jnp.einsum('bse,ed->bsd', mixed, w_out)


def setup_inputs(seed: int = 0) -> dict:
    key = jax.random.key(seed)
    ks = jax.random.split(key, 14)
    f32 = jnp.float32
    n = jax.random.normal
    return {
        "x": n(ks[0], (BATCH, SEQ, D_MODEL), f32),
        "attn_norm": 1.0 + 0.02 * n(ks[1], (DEPTH, D_MODEL), f32),
        "w_in": n(ks[2], (DEPTH, D_MODEL, 3 * MIX_WIDTH), f32) * D_MODEL ** -0.5,
        "lambda_q1": LAMBDA_STD * n(ks[3], (DEPTH, HEAD_DIM), f32),
        "lambda_k1": LAMBDA_STD * n(ks[4], (DEPTH, HEAD_DIM), f32),
        "lambda_q2": LAMBDA_STD * n(ks[5], (DEPTH, HEAD_DIM), f32),
        "lambda_k2": LAMBDA_STD * n(ks[6], (DEPTH, HEAD_DIM), f32),
        "diff_subln": 1.0 + 0.02 * n(ks[7], (DEPTH, 2 * HEAD_DIM), f32),
        "sb_subln": 1.0 + 0.02 * n(ks[8], (DEPTH, HEAD_DIM), f32),
        "w_out": n(ks[9], (DEPTH, MIX_WIDTH, D_MODEL), f32) * MIX_WIDTH ** -0.5,
        "mlp_norm": 1.0 + 0.02 * n(ks[10], (DEPTH, D_MODEL), f32),
        "w_up": n(ks[11], (DEPTH, D_MODEL, D_FF), f32) * D_MODEL ** -0.5,
        "w_down": n(ks[12], (DEPTH, D_FF, D_MODEL), f32) * D_FF ** -0.5,
        "final_norm": 1.0 + 0.02 * n(ks[13], (D_MODEL,), f32),
    }


def reference(x, attn_norm, w_in, lambda_q1, lambda_k1, lambda_q2, lambda_k2, diff_subln, sb_subln,
              w_out, mlp_norm, w_up, w_down, final_norm):
    h = x
    for l in range(DEPTH):
        a = rmsnorm(h, attn_norm[l])
        h = h + hybrid_mixer(a, w_in[l], lambda_q1[l], lambda_k1[l], lambda_q2[l], lambda_k2[l],
                             diff_subln[l], sb_subln[l], w_out[l], l)
        m = rmsnorm(h, mlp_norm[l])
        u = jnp.square(jax.nn.relu(jnp.einsum('bsd,df->bsf', m, w_up[l])))
        h = h + jnp.einsum('bsf,fd->bsd', u, w_down[l])
    return rmsnorm(h, final_norm)
```

```cpp
#include <hip/hip_runtime.h>
#include <hip/hip_cooperative_groups.h>
#include <cstdio>
#include <cstdint>
namespace cg = cooperative_groups;
namespace pg8 {
#define PG8_LAS __attribute__((address_space(3)))
typedef unsigned short bf16_t;
typedef short bf16x8 __attribute__((ext_vector_type(8)));
typedef float f32x4 __attribute__((ext_vector_type(4)));
typedef unsigned u32x4 __attribute__((ext_vector_type(4)));
constexpr int BM = 256, BK = 64, HALF = 128, HTB = HALF * BK * 2  , STAGE_BYTES = 8 * HTB, NXCD = 8, WGM = 8;

__host__ __device__ __forceinline__ int lds_byte(int r, int c) { const int st = (r >> 4) * 2 + (c >> 5), rr = r & 15, cc = c & 31, ob = rr * 64 + cc * 2; return st * 1024 + (ob ^ (((ob >> 9) & 1) << 5)); }
__host__ __device__ __forceinline__ void stage_rc(int b, int& R, int& C) { const int st = b / 1024, sb = b % 1024, swz = sb ^ (((sb >> 9) & 1) << 5); R = (st >> 1) * 16 + swz / 64; C = (st & 1) * 32 + (swz % 64) / 2; }
__host__ __device__ __forceinline__ int perm32(int rho) { const int n = rho >> 4, i = rho & 15; return 8 * (i >> 2) + 4 * n + (i & 3); }

struct Unit { int pm, pn; };
struct Gemm { const bf16_t* A; const bf16_t* Bt; int M, N, K; };

struct StaticOrder {
    int nM, nN, nwg, G, c;
    __host__ __device__ void init(int M, int N, int G_, int c_) { nM = M / BM; nN = N / BM; nwg = nM * nN; G = G_; c = c_; }
    __host__ __device__ bool next(int i, Unit& u) const {
        const long L = (long)i * G + c; if (L >= nwg) return false;
        int wgid = (int)L; { const int q = nwg / NXCD, r = nwg % NXCD, xcd = wgid % NXCD, off = wgid / NXCD; wgid = (xcd < r ? xcd * (q + 1) : r * (q + 1) + (xcd - r) * q) + off; }
        const int nig = WGM * nN, gid = wgid / nig, fm = gid * WGM, gsz = (nM - fm) < WGM ? (nM - fm) : WGM;
        u.pm = fm + ((wgid % nig) % gsz); u.pn = (wgid % nig) / gsz; return true;
    }
    __device__ __forceinline__ void a_ready(const Unit&) const {}
    __device__ __forceinline__ void done(const Unit&) const {}
};

__device__ __forceinline__ unsigned cvt_pk_bf16(float lo, float hi) { unsigned r; asm volatile("v_cvt_pk_bf16_f32 %0, %1, %2" : "=v"(r) : "v"(lo), "v"(hi)); return r; }
typedef unsigned u32x2 __attribute__((ext_vector_type(2)));
struct EpiBf16Plain {
    static constexpr bool PERM = true, AFTER_DRAIN = false;
    bf16_t* O; int ldc;
    __device__ __forceinline__ void operator()(const f32x4 (&acc)[2][2][4][2], const Unit& u, int wr, int wc, int fr, int fq) const {
        const int row0 = u.pm * BM + wr * 64 + fr; const int col0 = u.pn * BM + wc * 32 + 8 * fq;
#pragma unroll
        for (int ai = 0; ai < 2; ++ai)
#pragma unroll
            for (int m = 0; m < 4; ++m) { bf16_t* rowp = O + (size_t)(row0 + ai * HALF + m * 16) * ldc + col0;
#pragma unroll
                for (int bj = 0; bj < 2; ++bj) { const f32x4 v0 = acc[ai][bj][m][0], v1 = acc[ai][bj][m][1];
                    u32x4 w; w.x = cvt_pk_bf16(v0[0], v0[1]); w.y = cvt_pk_bf16(v0[2], v0[3]); w.z = cvt_pk_bf16(v1[0], v1[1]); w.w = cvt_pk_bf16(v1[2], v1[3]);
                    *(u32x4*)(rowp + bj * HALF) = w; } }
    }
};
struct EpiSqRelu {
    static constexpr bool PERM = true, AFTER_DRAIN = false;
    bf16_t* O; int ldc; const float* ss;
    __device__ __forceinline__ void operator()(const f32x4 (&acc)[2][2][4][2], const Unit& u, int wr, int wc, int fr, int fq) const {
        const int row0 = u.pm * BM + wr * 64 + fr; const int col0 = u.pn * BM + wc * 32 + 8 * fq;
#pragma unroll
        for (int ai = 0; ai < 2; ++ai)
#pragma unroll
            for (int m = 0; m < 4; ++m) { const int row = row0 + ai * HALF + m * 16; bf16_t* rowp = O + (size_t)row * ldc + col0;
                const float sv = __hip_atomic_load(ss + row, __ATOMIC_RELAXED, __HIP_MEMORY_SCOPE_AGENT);
                const float inv = rsqrtf(sv * (1.0f / 1024.0f) + 1e-6f), inv2 = inv * inv;
#pragma unroll
                for (int bj = 0; bj < 2; ++bj) { f32x4 v0 = acc[ai][bj][m][0], v1 = acc[ai][bj][m][1];
#pragma unroll
                    for (int e = 0; e < 4; ++e) { const float a = fmaxf(v0[e], 0.f), b = fmaxf(v1[e], 0.f); v0[e] = a * a * inv2; v1[e] = b * b * inv2; }
                    u32x4 w; w.x = cvt_pk_bf16(v0[0], v0[1]); w.y = cvt_pk_bf16(v0[2], v0[3]); w.z = cvt_pk_bf16(v1[0], v1[1]); w.w = cvt_pk_bf16(v1[2], v1[3]);
                    *(u32x4*)(rowp + bj * HALF) = w; } }
    }
};
struct EpiResid {
    static constexpr bool PERM = false, AFTER_DRAIN = false;
    const float* base; float* out; bf16_t* ob; float* ss; int ldc;
    __device__ __forceinline__ void operator()(const f32x4 (&acc)[2][2][4][2], const Unit& u, int wr, int wc, int fr, int fq) const {
        const int col0 = u.pn * BM + wc * 32 + 4 * fq;
#pragma unroll
        for (int ai = 0; ai < 2; ++ai)
#pragma unroll
            for (int m = 0; m < 4; ++m) { const int r = u.pm * BM + ai * HALF + wr * 64 + m * 16 + fr; const size_t off = (size_t)r * ldc + col0; float s = 0.f;
#pragma unroll
                for (int bj = 0; bj < 2; ++bj)
#pragma unroll
                    for (int n = 0; n < 2; ++n) { const f32x4 bs = *(const f32x4*)(base + off + bj * HALF + n * 16); const f32x4 o = bs + acc[ai][bj][m][n];
                        *(f32x4*)(out + off + bj * HALF + n * 16) = o; s += (o[0] * o[0] + o[1] * o[1]) + (o[2] * o[2] + o[3] * o[3]);
                        if (ob) { u32x2 w; w.x = cvt_pk_bf16(o[0], o[1]); w.y = cvt_pk_bf16(o[2], o[3]); *(u32x2*)(ob + off + bj * HALF + n * 16) = w; } }
                s += __shfl_xor(s, 16); s += __shfl_xor(s, 32);
                if (fq == 0) (void)__hip_atomic_fetch_add(ss + r, s, __ATOMIC_RELAXED, __HIP_MEMORY_SCOPE_AGENT); }
    }
};

template <class Epi, class Sched, bool ALIGN_EPI = false, bool SP2 = false>
__device__ __forceinline__ void gemm_phase(PG8_LAS unsigned char* lds, const Gemm g, const Sched& S, const Epi& E) {
    const int tid = threadIdx.x, wid = __builtin_amdgcn_readfirstlane(tid >> 6), lane = tid & 63, wr = wid >> 2, wc = wid & 3, fr = lane & 15, fq = lane >> 4;
    const int K = g.K, nt = K / BK;
    unsigned voffA[2], voffB[2];
#pragma unroll
    for (int i = 0; i < 2; ++i) { int R, C; stage_rc(tid * 16 + i * 8192, R, C); const int Rb = Epi::PERM ? ((R & ~31) + perm32(R & 31)) : R;
        voffA[i] = (unsigned)(R * K + C) * 2u; voffB[i] = (unsigned)(Rb * K + C) * 2u; }
    const size_t kstep = (size_t)(BK * 2);
    const size_t hstep = (size_t)HALF * K * 2;
    const size_t tstep = 2 * hstep;
    const unsigned ldsw = (unsigned)wid * 1024u;
    const int aoff = lds_byte(wr * 64 + fr, fq * 8), boff = lds_byte(wc * 32 + fr, fq * 8);
#define PG8_SA(b, h) (((b) * 2 + (h)) * HTB)
#define PG8_SB(b, h) ((4 + (b) * 2 + (h)) * HTB)
#define PG8_STAGE(bufoff, gbase, voff) do { _Pragma("unroll") for (int _i = 0; _i < 2; ++_i) \
        __builtin_amdgcn_global_load_lds((const unsigned*)((const char*)(gbase) + (voff)[_i]), (PG8_LAS unsigned*)(lds + (bufoff) + ldsw + _i * 8192), 16, 0, 0); } while (0)
#define PG8_LDA(dst, b, h) do { _Pragma("unroll") for (int m = 0; m < 4; ++m) _Pragma("unroll") for (int k = 0; k < 2; ++k) dst[m][k] = *(const PG8_LAS bf16x8*)(lds + PG8_SA(b, h) + aoff + m * 2048 + k * 1024); } while (0)
#define PG8_LDB(dst, b, h) do { _Pragma("unroll") for (int n = 0; n < 2; ++n) _Pragma("unroll") for (int k = 0; k < 2; ++k) dst[n][k] = *(const PG8_LAS bf16x8*)(lds + PG8_SB(b, h) + boff + n * 2048 + k * 1024); } while (0)
#define PG8_MMA(ai, bj, At, Bt) do { __builtin_amdgcn_s_setprio(1); _Pragma("unroll") for (int m = 0; m < 4; ++m) _Pragma("unroll") for (int n = 0; n < 2; ++n) _Pragma("unroll") for (int k = 0; k < 2; ++k) \
        acc[ai][bj][m][n] = __builtin_amdgcn_mfma_f32_16x16x32_bf16(Bt[n][k], At[m][k], acc[ai][bj][m][n], 0, 0, 0); __builtin_amdgcn_s_setprio(0); } while (0)
#define PG8_WAIT_V(n) asm volatile("s_waitcnt vmcnt(" #n ")" ::: "memory")
#define PG8_WAIT_L(n) asm volatile("s_waitcnt lgkmcnt(" #n ")" ::: "memory")
#define PG8_BAR __builtin_amdgcn_s_barrier()
#define PG8_SCHED __builtin_amdgcn_sched_barrier(0)
    Unit cur, nxt; int ui = 0;
    if (!S.next(0, cur)) return;
    f32x4 acc[2][2][4][2];
#pragma unroll
    for (int a = 0; a < 2; ++a)
#pragma unroll
        for (int b = 0; b < 2; ++b)
#pragma unroll
            for (int m = 0; m < 4; ++m)
#pragma unroll
                for (int n = 0; n < 2; ++n) acc[a][b][m][n] = (f32x4){0.f, 0.f, 0.f, 0.f};
    bf16x8 At[4][2], B0[2][2], B1[2][2];
    const char* cA = (const char*)g.A + (size_t)cur.pm * tstep; const char* cB = (const char*)g.Bt + (size_t)cur.pn * tstep;
    S.a_ready(cur);
    if constexpr (SP2) {
        PG8_STAGE(PG8_SB(0, 0), cB, voffB); PG8_STAGE(PG8_SB(0, 1), cB + hstep, voffB); PG8_STAGE(PG8_SA(0, 0), cA, voffA); PG8_STAGE(PG8_SA(0, 1), cA + hstep, voffA);
        if (wr == 1) PG8_BAR;
        PG8_WAIT_V(2); PG8_BAR;
        PG8_STAGE(PG8_SB(1, 0), cB + kstep, voffB); PG8_STAGE(PG8_SA(1, 0), cA + kstep, voffA); PG8_STAGE(PG8_SB(1, 1), cB + hstep + kstep, voffB);
        PG8_WAIT_V(6); PG8_BAR;
    } else {
        PG8_STAGE(PG8_SB(0, 0), cB, voffB); PG8_STAGE(PG8_SA(0, 0), cA, voffA); PG8_STAGE(PG8_SB(0, 1), cB + hstep, voffB); PG8_STAGE(PG8_SA(0, 1), cA + hstep, voffA);
        if (wr == 1) PG8_BAR;
        PG8_WAIT_V(4); PG8_BAR;
        PG8_STAGE(PG8_SB(1, 0), cB + kstep, voffB); PG8_STAGE(PG8_SA(1, 0), cA + kstep, voffA); PG8_STAGE(PG8_SB(1, 1), cB + hstep + kstep, voffB);
        PG8_WAIT_V(6); PG8_BAR;
    }
    for (;;) {
        const bool has_next = S.next(ui + 1, nxt);
        const char* nA = has_next ? (const char*)g.A + (size_t)nxt.pm * tstep : cA; const char* nB = has_next ? (const char*)g.Bt + (size_t)nxt.pn * tstep : cB;
        for (int t = 0; t < nt; t += 2) {
            const bool last = (t == nt - 2);
            const char* a1 = cA + (size_t)(t + 1) * kstep;
            const char* a2 = last ? nA : cA + (size_t)(t + 2) * kstep; const char* b2 = last ? nB : cB + (size_t)(t + 2) * kstep;
            const char* a3 = a2 + kstep; const char* b3 = b2 + kstep;
            if (last && has_next) S.a_ready(nxt);
            if constexpr (SP2) {
            PG8_LDB(B0, 0, 0); PG8_LDB(B1, 0, 1); PG8_SCHED; PG8_LDA(At, 0, 0); PG8_STAGE(PG8_SA(1, 1), a1 + hstep, voffA);
            PG8_WAIT_V(8); PG8_WAIT_L(0); PG8_BAR; PG8_MMA(0, 0, At, B0); PG8_MMA(0, 1, At, B1); PG8_BAR; PG8_SCHED;
            PG8_LDA(At, 0, 1); PG8_STAGE(PG8_SB(0, 0), b2, voffB); PG8_STAGE(PG8_SB(0, 1), b2 + hstep, voffB); PG8_STAGE(PG8_SA(0, 0), a2, voffA);
            PG8_WAIT_V(8); PG8_WAIT_L(0); PG8_BAR; PG8_MMA(1, 0, At, B0); PG8_MMA(1, 1, At, B1); PG8_BAR; PG8_SCHED;
            PG8_LDB(B0, 1, 0); PG8_LDB(B1, 1, 1); PG8_SCHED; PG8_LDA(At, 1, 0); PG8_STAGE(PG8_SA(0, 1), a2 + hstep, voffA);
            PG8_WAIT_V(8); PG8_WAIT_L(0); PG8_BAR; PG8_MMA(0, 0, At, B0); PG8_MMA(0, 1, At, B1); PG8_BAR; PG8_SCHED;
            PG8_LDA(At, 1, 1); PG8_STAGE(PG8_SB(1, 0), b3, voffB); PG8_STAGE(PG8_SB(1, 1), b3 + hstep, voffB); PG8_STAGE(PG8_SA(1, 0), a3, voffA);
            PG8_WAIT_V(8); PG8_WAIT_L(0); PG8_BAR; PG8_MMA(1, 0, At, B0); PG8_MMA(1, 1, At, B1); PG8_BAR; PG8_SCHED;
            } else {
            PG8_LDB(B0, 0, 0); PG8_SCHED; PG8_LDA(At, 0, 0); PG8_STAGE(PG8_SA(1, 1), a1 + hstep, voffA);
            PG8_WAIT_L(8); PG8_BAR; PG8_WAIT_L(0); PG8_MMA(0, 0, At, B0); PG8_BAR; PG8_SCHED;
            PG8_LDB(B1, 0, 1); PG8_STAGE(PG8_SB(0, 0), b2, voffB);
            PG8_BAR; PG8_WAIT_L(0); PG8_MMA(0, 1, At, B1); PG8_BAR;
            PG8_LDA(At, 0, 1); PG8_STAGE(PG8_SA(0, 0), a2, voffA);
            PG8_BAR; PG8_WAIT_L(0); PG8_MMA(1, 0, At, B0); PG8_BAR; PG8_SCHED;
            PG8_STAGE(PG8_SB(0, 1), b2 + hstep, voffB);
            PG8_WAIT_V(6); PG8_BAR; PG8_MMA(1, 1, At, B1); PG8_BAR;
            PG8_LDB(B0, 1, 0); PG8_SCHED; PG8_LDA(At, 1, 0); PG8_STAGE(PG8_SA(0, 1), a2 + hstep, voffA);
            PG8_WAIT_L(8); PG8_BAR; PG8_WAIT_L(0); PG8_MMA(0, 0, At, B0); PG8_BAR; PG8_SCHED;
            PG8_LDB(B1, 1, 1); PG8_STAGE(PG8_SB(1, 0), b3, voffB);
            PG8_BAR; PG8_WAIT_L(0); PG8_MMA(0, 1, At, B1); PG8_BAR;
            PG8_LDA(At, 1, 1); PG8_STAGE(PG8_SA(1, 0), a3, voffA);
            PG8_BAR; PG8_WAIT_L(0); PG8_MMA(1, 0, At, B0); PG8_BAR; PG8_SCHED;
            PG8_STAGE(PG8_SB(1, 1), b3 + hstep, voffB);
            PG8_WAIT_V(6); PG8_BAR; PG8_MMA(1, 1, At, B1); PG8_BAR;
            }
        }
        if constexpr (ALIGN_EPI) { if (wr == 0) PG8_BAR; }
        if constexpr (!Epi::AFTER_DRAIN) { E(acc, cur, wr, wc, fr, fq); S.done(cur); }
        if (!has_next) break;
#pragma unroll
        for (int a = 0; a < 2; ++a)
#pragma unroll
            for (int b = 0; b < 2; ++b)
#pragma unroll
                for (int m = 0; m < 4; ++m)
#pragma unroll
                    for (int n = 0; n < 2; ++n) acc[a][b][m][n] = (f32x4){0.f, 0.f, 0.f, 0.f};
        cur = nxt; cA = nA; cB = nB; ++ui;
        if constexpr (ALIGN_EPI) { if (wr == 1) PG8_BAR; }
    }
    PG8_WAIT_V(0);
    if constexpr (!ALIGN_EPI) { if (wr == 0) PG8_BAR; }
    PG8_BAR;
    if constexpr (Epi::AFTER_DRAIN) { E.fused(acc, cur, wr, wc, fr, fq, lds, wid, lane); S.done(cur); }
#undef PG8_SA
#undef PG8_SB
#undef PG8_STAGE
#undef PG8_LDA
#undef PG8_LDB
#undef PG8_MMA
#undef PG8_WAIT_V
#undef PG8_WAIT_L
#undef PG8_BAR
#undef PG8_SCHED
}
}
#ifndef PG8_SP2
#define PG8_SP2 true
#endif
#ifndef PG8_ALIGN
#define PG8_ALIGN true
#endif
constexpr int NWAVES = 8;
constexpr int BATCH = 16, SEQ = 2048, D = 1024, FF = 4096, NPROJ = 3072;
constexpr int M = BATCH * SEQ;
constexpr float EPS = 1e-6f;
constexpr int C_DQ = 0, C_DK = 512, C_DV = 1024, C_SQ = 1536, C_SK = 2048, C_SV = 2560;
constexpr size_t MiB = 1u << 20;
constexpr size_t WS_CTL = 0, CTL_ZERO_BYTES = 1 * MiB;
constexpr size_t WS_SS1 = 0, WS_SS2 = 256 * 1024;
constexpr size_t WS_WQKV = 2 * MiB, WS_WO = 8 * MiB, WS_W1 = 10 * MiB, WS_W2 = 18 * MiB;
constexpr size_t WS_XN = 32 * MiB;
constexpr size_t WS_PROJ = 96 * MiB;
constexpr size_t WS_MIX = 288 * MiB;
constexpr size_t WS_U = 96 * MiB;
constexpr size_t WS_END = 352 * MiB;
constexpr int RING_OFF = 0, RING_BYTES = 131072;
constexpr int LDS_BYTES = 147456;

#define GAS __attribute__((address_space(1)))
#define LAS __attribute__((address_space(3)))
typedef unsigned short bf16;
typedef unsigned v4u __attribute__((ext_vector_type(4)));
typedef float f32x4 __attribute__((ext_vector_type(4)));
#define LDS_WAIT() asm volatile("s_waitcnt lgkmcnt(0)" ::: "memory")
__device__ __forceinline__ unsigned f2bf(float f) { unsigned u = __builtin_bit_cast(unsigned, f); return (u + 0x7fffu + ((u >> 16) & 1u)) >> 16; }
__device__ __forceinline__ unsigned pk2(float lo, float hi) { return f2bf(lo) | (f2bf(hi) << 16); }
__device__ __forceinline__ float bflo(unsigned w) { return __builtin_bit_cast(float, w << 16); }
__device__ __forceinline__ float bfhi(unsigned w) { return __builtin_bit_cast(float, w & 0xffff0000u); }

struct Frame {
    LAS unsigned char* lds;
    int tid, lane, wave, vcu, G;
};
__device__ __forceinline__ float wave_sum(float v) {
#pragma unroll
    for (int o = 1; o < 64; o <<= 1) v += __shfl_xor(v, o);
    return v;
}
__device__ __forceinline__ void p0_transpose_item(const float* W, int K, int N, bf16* WT, const float* ks, LAS float* scr, int item, int lane) {
    const int nblk = N / 32, kb = item / nblk, nb = item % nblk, k0 = 64 * kb, n0 = 32 * nb;
#pragma unroll 8
    for (int i = 0; i < 32; ++i) { const int kk = 2 * i + (lane >> 5); float v = W[(size_t)(k0 + kk) * N + n0 + (lane & 31)]; if (ks) v *= ks[k0 + kk]; scr[kk * 33 + (lane & 31)] = v; }
    LDS_WAIT(); asm volatile("" ::: "memory");
    const int c = lane & 7;
#pragma unroll
    for (int j = 0; j < 4; ++j) { const int n = (lane >> 3) + 8 * j; const LAS float* s = scr + (8 * c) * 33 + n;
        v4u o; o.x = pk2(s[0 * 33], s[1 * 33]); o.y = pk2(s[2 * 33], s[3 * 33]); o.z = pk2(s[4 * 33], s[5 * 33]); o.w = pk2(s[6 * 33], s[7 * 33]);
        *(GAS v4u*)(WT + (size_t)(n0 + n) * K + k0 + 8 * c) = o; }
    LDS_WAIT(); asm volatile("" ::: "memory");
}
__device__ __forceinline__ void rms_row_to_bf16(int lane, const float* xrow, const float* g, bf16* orow) {
    const GAS f32x4* xr = (const GAS f32x4*)xrow + lane; const GAS f32x4* gr = (const GAS f32x4*)g + lane;
    f32x4 v[4]; float s = 0.f;
#pragma unroll
    for (int j = 0; j < 4; ++j) { v[j] = xr[64 * j]; s += (v[j].x * v[j].x + v[j].y * v[j].y) + (v[j].z * v[j].z + v[j].w * v[j].w); }
    const float inv = rsqrtf(wave_sum(s) * (1.f / D) + EPS);
    GAS unsigned long long* o8 = (GAS unsigned long long*)orow + lane;
#pragma unroll
    for (int j = 0; j < 4; ++j) { const f32x4 gg = gr[64 * j];
        o8[64 * j] = (unsigned long long)pk2(v[j].x * inv * gg.x, v[j].y * inv * gg.y) | ((unsigned long long)pk2(v[j].z * inv * gg.z, v[j].w * inv * gg.w) << 32); }
}
struct Args { const float* in[14]; float* out; unsigned char* ws; int ph_lo, ph_hi, coop, pad; };

__device__ __forceinline__ void p0_prologue(Frame& F, const Args& a) {
    LAS float* scr = (LAS float*)(F.lds + RING_OFF + F.wave * 16384);
    const int gw = F.vcu * NWAVES + F.wave, NGW = F.G * NWAVES;
    unsigned char* ws = a.ws;
    constexpr int I_IN = (D / 64) * (NPROJ / 32), I_O = (D / 64) * (D / 32), I_1 = (D / 64) * (FF / 32), I_2 = (FF / 64) * (D / 32);
    constexpr int NITEMS = I_IN + I_O + I_1 + I_2;
    for (int it = gw; it < NITEMS; it += NGW) {
        int r = it;
        if (r < I_IN) { p0_transpose_item(a.in[2], D, NPROJ, (bf16*)(ws + WS_WQKV), nullptr, scr, r, F.lane); continue; } r -= I_IN;
        if (r < I_O) { p0_transpose_item(a.in[9], D, D, (bf16*)(ws + WS_WO), nullptr, scr, r, F.lane); continue; } r -= I_O;
        if (r < I_1) { p0_transpose_item(a.in[11], D, FF, (bf16*)(ws + WS_W1), a.in[10], scr, r, F.lane); continue; } r -= I_1;
        p0_transpose_item(a.in[12], FF, D, (bf16*)(ws + WS_W2), nullptr, scr, r, F.lane);
    }
    for (int m = gw; m < M; m += NGW) rms_row_to_bf16(F.lane, a.in[0] + (size_t)m * D, a.in[1], (bf16*)(ws + WS_XN) + (size_t)m * D);
}
__device__ __forceinline__ void p6_final(Frame& F, const Args& a) {
    const int gw = F.vcu * NWAVES + F.wave, NGW = F.G * NWAVES;
    const float* ss2 = (const float*)(a.ws + WS_SS2); const GAS f32x4* gr = (const GAS f32x4*)a.in[13] + F.lane;
    f32x4 gg[4];
#pragma unroll
    for (int j = 0; j < 4; ++j) gg[j] = gr[64 * j];
    for (int m = gw; m < M; m += NGW) {
        const float inv = rsqrtf(__hip_atomic_load(ss2 + m, __ATOMIC_RELAXED, __HIP_MEMORY_SCOPE_AGENT) * (1.f / D) + EPS);
        GAS f32x4* o = (GAS f32x4*)(a.out + (size_t)m * D) + F.lane;
#pragma unroll
        for (int j = 0; j < 4; ++j) { f32x4 v = o[64 * j]; v = v * inv * gg[j]; o[64 * j] = v; }
    }
}
typedef unsigned u32x4g __attribute__((ext_vector_type(4)));
__device__ __forceinline__ float lam_of(const float* lq1, const float* lk1, const float* lq2, const float* lk2) {
    float s1 = 0.f, s2 = 0.f;
    for (int i = 0; i < 64; ++i) { s1 += lq1[i] * lk1[i]; s2 += lq2[i] * lk2[i]; }
    return __expf(s1) - __expf(s2) + 0.2f;
}
__global__ void __launch_bounds__(256) diff_scalar_k(const bf16* proj, bf16* mix, const float* lq1, const float* lk1, const float* lq2, const float* lk2, const float* g) {
    const int tl = threadIdx.x >> 1, half = threadIdx.x & 1;
    const int blk = blockIdx.x, qb = blk & 15, bh = blk >> 4, b = bh >> 2, h = bh & 3;
    const int t = qb * 128 + tl;
    const float lam = lam_of(lq1, lk1, lq2, lk2);
    const float slope = exp2f(-2.f * (float)(h + 1));
    const size_t rowb = (size_t)b * SEQ;
    float q1[64], q2[64], a1[64], a2[64];
    { const u32x4g* qp = (const u32x4g*)(proj + (rowb + t) * NPROJ + C_DQ + h * 128);
#pragma unroll
      for (int i = 0; i < 8; ++i) { const u32x4g w = qp[i], w2 = qp[8 + i];
#pragma unroll
        for (int e = 0; e < 4; ++e) { q1[8 * i + 2 * e] = bflo(w[e]) * 0.125f; q1[8 * i + 2 * e + 1] = bfhi(w[e]) * 0.125f; q2[8 * i + 2 * e] = bflo(w2[e]) * 0.125f; q2[8 * i + 2 * e + 1] = bfhi(w2[e]) * 0.125f; } } }
#pragma unroll
    for (int i = 0; i < 64; ++i) { a1[i] = 0.f; a2[i] = 0.f; }
    float m1 = -1e30f, l1 = 0.f, m2 = -1e30f, l2 = 0.f;
    for (int s = 0; s <= t; ++s) {
        const u32x4g* kp = (const u32x4g*)(proj + (rowb + s) * NPROJ + C_DK + h * 128);
        const u32x4g* vp = (const u32x4g*)(proj + (rowb + s) * NPROJ + C_DV + h * 128 + half * 64);
        float d1 = 0.f, d2 = 0.f;
#pragma unroll
        for (int i = 0; i < 8; ++i) { const u32x4g w = kp[i], w2 = kp[8 + i];
#pragma unroll
            for (int e = 0; e < 4; ++e) { d1 += q1[8 * i + 2 * e] * bflo(w[e]) + q1[8 * i + 2 * e + 1] * bfhi(w[e]); d2 += q2[8 * i + 2 * e] * bflo(w2[e]) + q2[8 * i + 2 * e + 1] * bfhi(w2[e]); } }
        const float bias = -slope * (float)(t - s);
        d1 += bias; d2 += bias;
        const float mn1 = fmaxf(m1, d1), sc1 = __expf(m1 - mn1), p1 = __expf(d1 - mn1); l1 = l1 * sc1 + p1; m1 = mn1;
        const float mn2 = fmaxf(m2, d2), sc2 = __expf(m2 - mn2), p2 = __expf(d2 - mn2); l2 = l2 * sc2 + p2; m2 = mn2;
#pragma unroll
        for (int i = 0; i < 8; ++i) { const u32x4g w = vp[i];
#pragma unroll
            for (int e = 0; e < 4; ++e) { const float v0 = bflo(w[e]), v1 = bfhi(w[e]);
                a1[8 * i + 2 * e] = a1[8 * i + 2 * e] * sc1 + p1 * v0; a1[8 * i + 2 * e + 1] = a1[8 * i + 2 * e + 1] * sc1 + p1 * v1;
                a2[8 * i + 2 * e] = a2[8 * i + 2 * e] * sc2 + p2 * v0; a2[8 * i + 2 * e + 1] = a2[8 * i + 2 * e + 1] * sc2 + p2 * v1; } }
    }
    const float r1 = 1.f / l1, r2 = lam / l2; float ssq = 0.f;
#pragma unroll
    for (int i = 0; i < 64; ++i) { a1[i] = a1[i] * r1 - a2[i] * r2; ssq += a1[i] * a1[i]; }
    ssq += __shfl_xor(ssq, 1);
    const float inv = rsqrtf(ssq * (1.f / 128.f) + EPS) * 0.8f;
    unsigned* op = (unsigned*)(mix + (rowb + t) * D + h * 128 + half * 64);
#pragma unroll
    for (int i = 0; i < 32; ++i) op[i] = pk2(a1[2 * i] * inv * g[half * 64 + 2 * i], a1[2 * i + 1] * inv * g[half * 64 + 2 * i + 1]);
}
__global__ void __launch_bounds__(256) sb_scalar_k(const bf16* proj, bf16* mix, const float* g) {
    const int blk = blockIdx.x, qb = blk & 7, bh = blk >> 3, b = bh >> 3, h = bh & 7;
    const int t = qb * 256 + threadIdx.x;
    const size_t rowb = (size_t)b * SEQ;
    float q[64], acc[64];
    { const u32x4g* qp = (const u32x4g*)(proj + (rowb + t) * NPROJ + C_SQ + h * 64);
#pragma unroll
      for (int i = 0; i < 8; ++i) { const u32x4g w = qp[i];
#pragma unroll
        for (int e = 0; e < 4; ++e) { q[8 * i + 2 * e] = bflo(w[e]) * 0.125f; q[8 * i + 2 * e + 1] = bfhi(w[e]) * 0.125f; } } }
#pragma unroll
    for (int i = 0; i < 64; ++i) acc[i] = 0.f;
    float R = 0.f;
    for (int s = t - 1; s >= 0; --s) {
        const u32x4g* kp = (const u32x4g*)(proj + (rowb + s) * NPROJ + C_SK + h * 64);
        const u32x4g* vp = (const u32x4g*)(proj + (rowb + s) * NPROJ + C_SV + h * 64);
        float z = 0.f;
#pragma unroll
        for (int i = 0; i < 8; ++i) { const u32x4g w = kp[i];
#pragma unroll
            for (int e = 0; e < 4; ++e) z += q[8 * i + 2 * e] * bflo(w[e]) + q[8 * i + 2 * e + 1] * bfhi(w[e]); }
        const float ls = fminf(z, 0.f) - log1pf(__expf(-fabsf(z)));
        const float w_ = __expf(ls + R);
#pragma unroll
        for (int i = 0; i < 8; ++i) { const u32x4g w = vp[i];
#pragma unroll
            for (int e = 0; e < 4; ++e) { acc[8 * i + 2 * e] += w_ * bflo(w[e]); acc[8 * i + 2 * e + 1] += w_ * bfhi(w[e]); } }
        R += ls - z;
        if (R < -110.f) break;
    }
    float ssq = 0.f;
#pragma unroll
    for (int i = 0; i < 64; ++i) ssq += acc[i] * acc[i];
    const float inv = rsqrtf(ssq * (1.f / 64.f) + EPS);
    unsigned* op = (unsigned*)(mix + (rowb + t) * D + 512 + h * 64);
#pragma unroll
    for (int i = 0; i < 32; ++i) op[i] = pk2(acc[2 * i] * inv * g[2 * i], acc[2 * i + 1] * inv * g[2 * i + 1]);
}
__global__ void __launch_bounds__(NWAVES * 64, 2) fwd(Args args) {
    extern __shared__ __attribute__((aligned(16))) unsigned char lds[];
    Frame F;
    F.lds = (LAS unsigned char*)lds;
    F.tid = threadIdx.x; F.lane = F.tid & 63; F.wave = __builtin_amdgcn_readfirstlane(F.tid >> 6);
    F.G = gridDim.x; { const int bx = blockIdx.x; F.vcu = (F.G % 8 == 0) ? (bx % 8) * (F.G / 8) + bx / 8 : bx; }
    unsigned char* ws = args.ws;
    const int lo = args.ph_lo, hi = args.ph_hi;
#define IN(k) (lo <= (k) && (k) < hi)
#define SEAM(k) do { if (IN(k) && IN((k) + 1)) { cg::this_grid().sync(); } } while (0)
    if (IN(0)) { p0_prologue(F, args); } SEAM(0);
    if (IN(1)) {
        pg8::Gemm g{(const bf16*)(ws + WS_XN), (const bf16*)(ws + WS_WQKV), M, NPROJ, D}; pg8::StaticOrder S; S.init(M, NPROJ, F.G, (int)blockIdx.x);
        pg8::EpiBf16Plain E{(bf16*)(ws + WS_PROJ), NPROJ};
        pg8::gemm_phase<pg8::EpiBf16Plain, pg8::StaticOrder, PG8_ALIGN, PG8_SP2>(F.lds + RING_OFF, g, S, E);
    } SEAM(1);
    SEAM(2);
    if (IN(3)) {
        pg8::Gemm g{(const bf16*)(ws + WS_MIX), (const bf16*)(ws + WS_WO), M, D, D}; pg8::StaticOrder S; S.init(M, D, F.G, (int)blockIdx.x);
        pg8::EpiResid E{args.in[0], args.out, (bf16*)(ws + WS_XN), (float*)(ws + WS_SS1), D};
        pg8::gemm_phase<pg8::EpiResid, pg8::StaticOrder, PG8_ALIGN, PG8_SP2>(F.lds + RING_OFF, g, S, E);
    } SEAM(3);
    if (IN(4)) {
        pg8::Gemm g{(const bf16*)(ws + WS_XN), (const bf16*)(ws + WS_W1), M, FF, D}; pg8::StaticOrder S; S.init(M, FF, F.G, (int)blockIdx.x);
        pg8::EpiSqRelu E{(bf16*)(ws + WS_U), FF, (const float*)(ws + WS_SS1)};
        pg8::gemm_phase<pg8::EpiSqRelu, pg8::StaticOrder, PG8_ALIGN, PG8_SP2>(F.lds + RING_OFF, g, S, E);
    } SEAM(4);
    if (IN(5)) {
        pg8::Gemm g{(const bf16*)(ws + WS_U), (const bf16*)(ws + WS_W2), M, D, FF}; pg8::StaticOrder S; S.init(M, D, F.G, (int)blockIdx.x);
        pg8::EpiResid E{args.out, args.out, nullptr, (float*)(ws + WS_SS2), D};
        pg8::gemm_phase<pg8::EpiResid, pg8::StaticOrder, PG8_ALIGN, PG8_SP2>(F.lds + RING_OFF, g, S, E);
    } SEAM(5);
    if (IN(6)) { p6_final(F, args); }
#undef IN
#undef SEAM
}

extern "C" void kernel_launch(void* const* d_in, const int* in_sizes, int n_in, void* d_out, int out_size, void* d_ws, size_t ws_size, hipStream_t stream) {
    static int grid = 0;
    if (grid == 0) {
        if (n_in != 14 || in_sizes[0] != M * D || out_size != M * D || ws_size < WS_END) { fprintf(stderr, "kernel_launch: unexpected shapes (n_in %d, in0 %d, out %d, ws %zu)\n", n_in, n_in > 0 ? in_sizes[0] : -1, out_size, ws_size); grid = -1; return; }
        int dev = 0, cus = 0;
        if (hipGetDevice(&dev) != hipSuccess || hipDeviceGetAttribute(&cus, hipDeviceAttributeMultiprocessorCount, dev) != hipSuccess) { grid = -1; return; }
        if (hipFuncSetAttribute((const void*)fwd, hipFuncAttributeMaxDynamicSharedMemorySize, LDS_BYTES) != hipSuccess) { fprintf(stderr, "kernel_launch: hipFuncSetAttribute failed\n"); grid = -1; return; }
        grid = cus;
    }
    if (grid < 0) return;
    (void)hipMemsetAsync((char*)d_ws + WS_CTL, 0, CTL_ZERO_BYTES, stream);
    Args a{};
    for (int i = 0; i < 14; ++i) a.in[i] = (const float*)d_in[i];
    a.out = (float*)d_out; a.ws = (unsigned char*)d_ws; a.coop = 0; a.pad = 0;
    unsigned char* ws = (unsigned char*)d_ws;
    auto launch = [&](int lo, int hi) { a.ph_lo = lo; a.ph_hi = hi; hipLaunchKernelGGL(fwd, dim3(grid), dim3(NWAVES * 64), LDS_BYTES, stream, a); };
    launch(0, 1); launch(1, 2);
    hipLaunchKernelGGL(diff_scalar_k, dim3(BATCH * 4 * 16), dim3(256), 0, stream, (const bf16*)(ws + WS_PROJ), (bf16*)(ws + WS_MIX), a.in[3], a.in[4], a.in[5], a.in[6], a.in[7]);
    hipLaunchKernelGGL(sb_scalar_k, dim3(BATCH * 8 * 8), dim3(256), 0, stream, (const bf16*)(ws + WS_PROJ), (bf16*)(ws + WS_MIX), a.in[8]);
    launch(3, 4); launch(4, 5); launch(5, 6); launch(6, 7);
}
```

```cpp
#include <hip/hip_runtime.h>
#include <hip/hip_cooperative_groups.h>
#include <cstdio>
#include <cstdint>
namespace cg = cooperative_groups;
namespace pg8 {
#define PG8_LAS __attribute__((address_space(3)))
typedef unsigned short bf16_t;
typedef short bf16x8 __attribute__((ext_vector_type(8)));
typedef float f32x4 __attribute__((ext_vector_type(4)));
typedef unsigned u32x4 __attribute__((ext_vector_type(4)));
constexpr int BM = 256, BK = 64, HALF = 128, HTB = HALF * BK * 2  , STAGE_BYTES = 8 * HTB, NXCD = 8, WGM = 8;

__host__ __device__ __forceinline__ int lds_byte(int r, int c) { const int st = (r >> 4) * 2 + (c >> 5), rr = r & 15, cc = c & 31, ob = rr * 64 + cc * 2; return st * 1024 + (ob ^ (((ob >> 9) & 1) << 5)); }
__host__ __device__ __forceinline__ void stage_rc(int b, int& R, int& C) { const int st = b / 1024, sb = b % 1024, swz = sb ^ (((sb >> 9) & 1) << 5); R = (st >> 1) * 16 + swz / 64; C = (st & 1) * 32 + (swz % 64) / 2; }
__host__ __device__ __forceinline__ int perm32(int rho) { const int n = rho >> 4, i = rho & 15; return 8 * (i >> 2) + 4 * n + (i & 3); }

struct Unit { int pm, pn; };
struct Gemm { const bf16_t* A; const bf16_t* Bt; int M, N, K; };

struct StaticOrder {
    int nM, nN, nwg, G, c;
    __host__ __device__ void init(int M, int N, int G_, int c_) { nM = M / BM; nN = N / BM; nwg = nM * nN; G = G_; c = c_; }
    __host__ __device__ bool next(int i, Unit& u) const {
        const long L = (long)i * G + c; if (L >= nwg) return false;
        int wgid = (int)L; { const int q = nwg / NXCD, r = nwg % NXCD, xcd = wgid % NXCD, off = wgid / NXCD; wgid = (xcd < r ? xcd * (q + 1) : r * (q + 1) + (xcd - r) * q) + off; }
        const int nig = WGM * nN, gid = wgid / nig, fm = gid * WGM, gsz = (nM - fm) < WGM ? (nM - fm) : WGM;
        u.pm = fm + ((wgid % nig) % gsz); u.pn = (wgid % nig) / gsz; return true;
    }
    __device__ __forceinline__ void a_ready(const Unit&) const {}
    __device__ __forceinline__ void done(const Unit&) const {}
};

__device__ __forceinline__ unsigned cvt_pk_bf16(float lo, float hi) { unsigned r; asm volatile("v_cvt_pk_bf16_f32 %0, %1, %2" : "=v"(r) : "v"(lo), "v"(hi)); return r; }
typedef unsigned u32x2 __attribute__((ext_vector_type(2)));
struct EpiBf16Plain {
    static constexpr bool PERM = true, AFTER_DRAIN = false;
    bf16_t* O; int ldc;
    __device__ __forceinline__ void operator()(const f32x4 (&acc)[2][2][4][2], const Unit& u, int wr, int wc, int fr, int fq) const {
        const int row0 = u.pm * BM + wr * 64 + fr; const int col0 = u.pn * BM + wc * 32 + 8 * fq;
#pragma unroll
        for (int ai = 0; ai < 2; ++ai)
#pragma unroll
            for (int m = 0; m < 4; ++m) { bf16_t* rowp = O + (size_t)(row0 + ai * HALF + m * 16) * ldc + col0;
#pragma unroll
                for (int bj = 0; bj < 2; ++bj) { const f32x4 v0 = acc[ai][bj][m][0], v1 = acc[ai][bj][m][1];
                    u32x4 w; w.x = cvt_pk_bf16(v0[0], v0[1]); w.y = cvt_pk_bf16(v0[2], v0[3]); w.z = cvt_pk_bf16(v1[0], v1[1]); w.w = cvt_pk_bf16(v1[2], v1[3]);
                    *(u32x4*)(rowp + bj * HALF) = w; } }
    }
};
struct EpiSqRelu {
    static constexpr bool PERM = true, AFTER_DRAIN = false;
    bf16_t* O; int ldc; const float* ss;
    __device__ __forceinline__ void operator()(const f32x4 (&acc)[2][2][4][2], const Unit& u, int wr, int wc, int fr, int fq) const {
        const int row0 = u.pm * BM + wr * 64 + fr; const int col0 = u.pn * BM + wc * 32 + 8 * fq;
#pragma unroll
        for (int ai = 0; ai < 2; ++ai)
#pragma unroll
            for (int m = 0; m < 4; ++m) { const int row = row0 + ai * HALF + m * 16; bf16_t* rowp = O + (size_t)row * ldc + col0;
                const float sv = __hip_atomic_load(ss + row, __ATOMIC_RELAXED, __HIP_MEMORY_SCOPE_AGENT);
                const float inv = rsqrtf(sv * (1.0f / 1024.0f) + 1e-6f), inv2 = inv * inv;
#pragma unroll
                for (int bj = 0; bj < 2; ++bj) { f32x4 v0 = acc[ai][bj][m][0], v1 = acc[ai][bj][m][1];
#pragma unroll
                    for (int e = 0; e < 4; ++e) { const float a = fmaxf(v0[e], 0.f), b = fmaxf(v1[e], 0.f); v0[e] = a * a * inv2; v1[e] = b * b * inv2; }
                    u32x4 w; w.x = cvt_pk_bf16(v0[0], v0[1]); w.y = cvt_pk_bf16(v0[2], v0[3]); w.z = cvt_pk_bf16(v1[0], v1[1]); w.w = cvt_pk_bf16(v1[2], v1[3]);
                    *(u32x4*)(rowp + bj * HALF) = w; } }
    }
};
struct EpiResid {
    static constexpr bool PERM = false, AFTER_DRAIN = false;
    const float* base; float* out; bf16_t* ob; float* ss; int ldc;
    __device__ __forceinline__ void operator()(const f32x4 (&acc)[2][2][4][2], const Unit& u, int wr, int wc, int fr, int fq) const {
        const int col0 = u.pn * BM + wc * 32 + 4 * fq;
#pragma unroll
        for (int ai = 0; ai < 2; ++ai)
#pragma unroll
            for (int m = 0; m < 4; ++m) { const int r = u.pm * BM + ai * HALF + wr * 64 + m * 16 + fr; const size_t off = (size_t)r * ldc + col0; float s = 0.f;
#pragma unroll
                for (int bj = 0; bj < 2; ++bj)
#pragma unroll
                    for (int n = 0; n < 2; ++n) { const f32x4 bs = *(const f32x4*)(base + off + bj * HALF + n * 16); const f32x4 o = bs + acc[ai][bj][m][n];
                        *(f32x4*)(out + off + bj * HALF + n * 16) = o; s += (o[0] * o[0] + o[1] * o[1]) + (o[2] * o[2] + o[3] * o[3]);
                        if (ob) { u32x2 w; w.x = cvt_pk_bf16(o[0], o[1]); w.y = cvt_pk_bf16(o[2], o[3]); *(u32x2*)(ob + off + bj * HALF + n * 16) = w; } }
                s += __shfl_xor(s, 16); s += __shfl_xor(s, 32);
                if (fq == 0) (void)__hip_atomic_fetch_add(ss + r, s, __ATOMIC_RELAXED, __HIP_MEMORY_SCOPE_AGENT); }
    }
};

template <class Epi, class Sched, bool ALIGN_EPI = false, bool SP2 = false>
__device__ __forceinline__ void gemm_phase(PG8_LAS unsigned char* lds, const Gemm g, const Sched& S, const Epi& E) {
    const int tid = threadIdx.x, wid = __builtin_amdgcn_readfirstlane(tid >> 6), lane = tid & 63, wr = wid >> 2, wc = wid & 3, fr = lane & 15, fq = lane >> 4;
    const int K = g.K, nt = K / BK;
    unsigned voffA[2], voffB[2];
#pragma unroll
    for (int i = 0; i < 2; ++i) { int R, C; stage_rc(tid * 16 + i * 8192, R, C); const int Rb = Epi::PERM ? ((R & ~31) + perm32(R & 31)) : R;
        voffA[i] = (unsigned)(R * K + C) * 2u; voffB[i] = (unsigned)(Rb * K + C) * 2u; }
    const size_t kstep = (size_t)(BK * 2);
    const size_t hstep = (size_t)HALF * K * 2;
    const size_t tstep = 2 * hstep;
    const unsigned ldsw = (unsigned)wid * 1024u;
    const int aoff = lds_byte(wr * 64 + fr, fq * 8), boff = lds_byte(wc * 32 + fr, fq * 8);
#define PG8_SA(b, h) (((b) * 2 + (h)) * HTB)
#define PG8_SB(b, h) ((4 + (b) * 2 + (h)) * HTB)
#define PG8_STAGE(bufoff, gbase, voff) do { _Pragma("unroll") for (int _i = 0; _i < 2; ++_i) \
        __builtin_amdgcn_global_load_lds((const unsigned*)((const char*)(gbase) + (voff)[_i]), (PG8_LAS unsigned*)(lds + (bufoff) + ldsw + _i * 8192), 16, 0, 0); } while (0)
#define PG8_LDA(dst, b, h) do { _Pragma("unroll") for (int m = 0; m < 4; ++m) _Pragma("unroll") for (int k = 0; k < 2; ++k) dst[m][k] = *(const PG8_LAS bf16x8*)(lds + PG8_SA(b, h) + aoff + m * 2048 + k * 1024); } while (0)
#define PG8_LDB(dst, b, h) do { _Pragma("unroll") for (int n = 0; n < 2; ++n) _Pragma("unroll") for (int k = 0; k < 2; ++k) dst[n][k] = *(const PG8_LAS bf16x8*)(lds + PG8_SB(b, h) + boff + n * 2048 + k * 1024); } while (0)
#define PG8_MMA(ai, bj, At, Bt) do { __builtin_amdgcn_s_setprio(1); _Pragma("unroll") for (int m = 0; m < 4; ++m) _Pragma("unroll") for (int n = 0; n < 2; ++n) _Pragma("unroll") for (int k = 0; k < 2; ++k) \
        acc[ai][bj][m][n] = __builtin_amdgcn_mfma_f32_16x16x32_bf16(Bt[n][k], At[m][k], acc[ai][bj][m][n], 0, 0, 0); __builtin_amdgcn_s_setprio(0); } while (0)
#define PG8_WAIT_V(n) asm volatile("s_waitcnt vmcnt(" #n ")" ::: "memory")
#define PG8_WAIT_L(n) asm volatile("s_waitcnt lgkmcnt(" #n ")" ::: "memory")
#define PG8_BAR __builtin_amdgcn_s_barrier()
#define PG8_SCHED __builtin_amdgcn_sched_barrier(0)
    Unit cur, nxt; int ui = 0;
    if (!S.next(0, cur)) return;
    f32x4 acc[2][2][4][2];
#pragma unroll
    for (int a = 0; a < 2; ++a)
#pragma unroll
        for (int b = 0; b < 2; ++b)
#pragma unroll
            for (int m = 0; m < 4; ++m)
#pragma unroll
                for (int n = 0; n < 2; ++n) acc[a][b][m][n] = (f32x4){0.f, 0.f, 0.f, 0.f};
    bf16x8 At[4][2], B0[2][2], B1[2][2];
    const char* cA = (const char*)g.A + (size_t)cur.pm * tstep; const char* cB = (const char*)g.Bt + (size_t)cur.pn * tstep;
    S.a_ready(cur);
    if constexpr (SP2) {
        PG8_STAGE(PG8_SB(0, 0), cB, voffB); PG8_STAGE(PG8_SB(0, 1), cB + hstep, voffB); PG8_STAGE(PG8_SA(0, 0), cA, voffA); PG8_STAGE(PG8_SA(0, 1), cA + hstep, voffA);
        if (wr == 1) PG8_BAR;
        PG8_WAIT_V(2); PG8_BAR;
        PG8_STAGE(PG8_SB(1, 0), cB + kstep, voffB); PG8_STAGE(PG8_SA(1, 0), cA + kstep, voffA); PG8_STAGE(PG8_SB(1, 1), cB + hstep + kstep, voffB);
        PG8_WAIT_V(6); PG8_BAR;
    } else {
        PG8_STAGE(PG8_SB(0, 0), cB, voffB); PG8_STAGE(PG8_SA(0, 0), cA, voffA); PG8_STAGE(PG8_SB(0, 1), cB + hstep, voffB); PG8_STAGE(PG8_SA(0, 1), cA + hstep, voffA);
        if (wr == 1) PG8_BAR;
        PG8_WAIT_V(4); PG8_BAR;
        PG8_STAGE(PG8_SB(1, 0), cB + kstep, voffB); PG8_STAGE(PG8_SA(1, 0), cA + kstep, voffA); PG8_STAGE(PG8_SB(1, 1), cB + hstep + kstep, voffB);
        PG8_WAIT_V(6); PG8_BAR;
    }
    for (;;) {
        const bool has_next = S.next(ui + 1, nxt);
        const char* nA = has_next ? (const char*)g.A + (size_t)nxt.pm * tstep : cA; const char* nB = has_next ? (const char*)g.Bt + (size_t)nxt.pn * tstep : cB;
        for (int t = 0; t < nt; t += 2) {
            const bool last = (t == nt - 2);
            const char* a1 = cA + (size_t)(t + 1) * kstep;
            const char* a2 = last ? nA : cA + (size_t)(t + 2) * kstep; const char* b2 = last ? nB : cB + (size_t)(t + 2) * kstep;
            const char* a3 = a2 + kstep; const char* b3 = b2 + kstep;
            if (last && has_next) S.a_ready(nxt);
            if constexpr (SP2) {
            PG8_LDB(B0, 0, 0); PG8_LDB(B1, 0, 1); PG8_SCHED; PG8_LDA(At, 0, 0); PG8_STAGE(PG8_SA(1, 1), a1 + hstep, voffA);
            PG8_WAIT_V(8); PG8_WAIT_L(0); PG8_BAR; PG8_MMA(0, 0, At, B0); PG8_MMA(0, 1, At, B1); PG8_BAR; PG8_SCHED;
            PG8_LDA(At, 0, 1); PG8_STAGE(PG8_SB(0, 0), b2, voffB); PG8_STAGE(PG8_SB(0, 1), b2 + hstep, voffB); PG8_STAGE(PG8_SA(0, 0), a2, voffA);
            PG8_WAIT_V(8); PG8_WAIT_L(0); PG8_BAR; PG8_MMA(1, 0, At, B0); PG8_MMA(1, 1, At, B1); PG8_BAR; PG8_SCHED;
            PG8_LDB(B0, 1, 0); PG8_LDB(B1, 1, 1); PG8_SCHED; PG8_LDA(At, 1, 0); PG8_STAGE(PG8_SA(0, 1), a2 + hstep, voffA);
            PG8_WAIT_V(8); PG8_WAIT_L(0); PG8_BAR; PG8_MMA(0, 0, At, B0); PG8_MMA(0, 1, At, B1); PG8_BAR; PG8_SCHED;
            PG8_LDA(At, 1, 1); PG8_STAGE(PG8_SB(1, 0), b3, voffB); PG8_STAGE(PG8_SB(1, 1), b3 + hstep, voffB); PG8_STAGE(PG8_SA(1, 0), a3, voffA);
            PG8_WAIT_V(8); PG8_WAIT_L(0); PG8_BAR; PG8_MMA(1, 0, At, B0); PG8_MMA(1, 1, At, B1); PG8_BAR; PG8_SCHED;
            } else {
            PG8_LDB(B0, 0, 0); PG8_SCHED; PG8_LDA(At, 0, 0); PG8_STAGE(PG8_SA(1, 1), a1 + hstep, voffA);
            PG8_WAIT_L(8); PG8_BAR; PG8_WAIT_L(0); PG8_MMA(0, 0, At, B0); PG8_BAR; PG8_SCHED;
            PG8_LDB(B1, 0, 1); PG8_STAGE(PG8_SB(0, 0), b2, voffB);
            PG8_BAR; PG8_WAIT_L(0); PG8_MMA(0, 1, At, B1); PG8_BAR;
            PG8_LDA(At, 0, 1); PG8_STAGE(PG8_SA(0, 0), a2, voffA);
            PG8_BAR; PG8_WAIT_L(0); PG8_MMA(1, 0, At, B0); PG8_BAR; PG8_SCHED;
            PG8_STAGE(PG8_SB(0, 1), b2 + hstep, voffB);
            PG8_WAIT_V(6); PG8_BAR; PG8_MMA(1, 1, At, B1); PG8_BAR;
            PG8_LDB(B0, 1, 0); PG8_SCHED; PG8_LDA(At, 1, 0); PG8_STAGE(PG8_SA(0, 1), a2 + hstep, voffA);
            PG8_WAIT_L(8); PG8_BAR; PG8_WAIT_L(0); PG8_MMA(0, 0, At, B0); PG8_BAR; PG8_SCHED;
            PG8_LDB(B1, 1, 1); PG8_STAGE(PG8_SB(1, 0), b3, voffB);
            PG8_BAR; PG8_WAIT_L(0); PG8_MMA(0, 1, At, B1); PG8_BAR;
            PG8_LDA(At, 1, 1); PG8_STAGE(PG8_SA(1, 0), a3, voffA);
            PG8_BAR; PG8_WAIT_L(0); PG8_MMA(1, 0, At, B0); PG8_BAR; PG8_SCHED;
            PG8_STAGE(PG8_SB(1, 1), b3 + hstep, voffB);
            PG8_WAIT_V(6); PG8_BAR; PG8_MMA(1, 1, At, B1); PG8_BAR;
            }
        }
        if constexpr (ALIGN_EPI) { if (wr == 0) PG8_BAR; }
        if constexpr (!Epi::AFTER_DRAIN) { E(acc, cur, wr, wc, fr, fq); S.done(cur); }
        if (!has_next) break;
#pragma unroll
        for (int a = 0; a < 2; ++a)
#pragma unroll
            for (int b = 0; b < 2; ++b)
#pragma unroll
                for (int m = 0; m < 4; ++m)
#pragma unroll
                    for (int n = 0; n < 2; ++n) acc[a][b][m][n] = (f32x4){0.f, 0.f, 0.f, 0.f};
        cur = nxt; cA = nA; cB = nB; ++ui;
        if constexpr (ALIGN_EPI) { if (wr == 1) PG8_BAR; }
    }
    PG8_WAIT_V(0);
    if constexpr (!ALIGN_EPI) { if (wr == 0) PG8_BAR; }
    PG8_BAR;
    if constexpr (Epi::AFTER_DRAIN) { E.fused(acc, cur, wr, wc, fr, fq, lds, wid, lane); S.done(cur); }
#undef PG8_SA
#undef PG8_SB
#undef PG8_STAGE
#undef PG8_LDA
#undef PG8_LDB
#undef PG8_MMA
#undef PG8_WAIT_V
#undef PG8_WAIT_L
#undef PG8_BAR
#undef PG8_SCHED
}
}
#ifndef PG8_SP2
#define PG8_SP2 true
#endif
#ifndef PG8_ALIGN
#define PG8_ALIGN true
#endif
constexpr int NWAVES = 8;
constexpr int BATCH = 16, SEQ = 2048, D = 1024, FF = 4096, NPROJ = 3072;
constexpr int M = BATCH * SEQ;
constexpr float EPS = 1e-6f;
constexpr int C_DQ = 0, C_DK = 512, C_DV = 1024, C_SQ = 1536, C_SK = 2048, C_SV = 2560;
constexpr size_t MiB = 1u << 20;
constexpr size_t WS_CTL = 0, CTL_ZERO_BYTES = 1 * MiB;
constexpr size_t WS_SS1 = 0, WS_SS2 = 256 * 1024;
constexpr size_t WS_WQKV = 2 * MiB, WS_WO = 8 * MiB, WS_W1 = 10 * MiB, WS_W2 = 18 * MiB;
constexpr size_t WS_XN = 32 * MiB;
constexpr size_t WS_PROJ = 96 * MiB;
constexpr size_t WS_MIX = 288 * MiB;
constexpr size_t WS_U = 96 * MiB;
constexpr size_t WS_END = 352 * MiB;
constexpr int RING_OFF = 0, RING_BYTES = 131072;
constexpr int LDS_BYTES = 147456;

#define GAS __attribute__((address_space(1)))
#define LAS __attribute__((address_space(3)))
typedef unsigned short bf16;
typedef unsigned v4u __attribute__((ext_vector_type(4)));
typedef float f32x4 __attribute__((ext_vector_type(4)));
#define LDS_WAIT() asm volatile("s_waitcnt lgkmcnt(0)" ::: "memory")
__device__ __forceinline__ unsigned f2bf(float f) { unsigned u = __builtin_bit_cast(unsigned, f); return (u + 0x7fffu + ((u >> 16) & 1u)) >> 16; }
__device__ __forceinline__ unsigned pk2(float lo, float hi) { return f2bf(lo) | (f2bf(hi) << 16); }
__device__ __forceinline__ float bflo(unsigned w) { return __builtin_bit_cast(float, w << 16); }
__device__ __forceinline__ float bfhi(unsigned w) { return __builtin_bit_cast(float, w & 0xffff0000u); }

struct Frame {
    LAS unsigned char* lds;
    int tid, lane, wave, vcu, G;
};
__device__ __forceinline__ float wave_sum(float v) {
#pragma unroll
    for (int o = 1; o < 64; o <<= 1) v += __shfl_xor(v, o);
    return v;
}
__device__ __forceinline__ void p0_transpose_item(const float* W, int K, int N, bf16* WT, const float* ks, LAS float* scr, int item, int lane) {
    const int nblk = N / 32, kb = item / nblk, nb = item % nblk, k0 = 64 * kb, n0 = 32 * nb;
#pragma unroll 8
    for (int i = 0; i < 32; ++i) { const int kk = 2 * i + (lane >> 5); float v = W[(size_t)(k0 + kk) * N + n0 + (lane & 31)]; if (ks) v *= ks[k0 + kk]; scr[kk * 33 + (lane & 31)] = v; }
    LDS_WAIT(); asm volatile("" ::: "memory");
    const int c = lane & 7;
#pragma unroll
    for (int j = 0; j < 4; ++j) { const int n = (lane >> 3) + 8 * j; const LAS float* s = scr + (8 * c) * 33 + n;
        v4u o; o.x = pk2(s[0 * 33], s[1 * 33]); o.y = pk2(s[2 * 33], s[3 * 33]); o.z = pk2(s[4 * 33], s[5 * 33]); o.w = pk2(s[6 * 33], s[7 * 33]);
        *(GAS v4u*)(WT + (size_t)(n0 + n) * K + k0 + 8 * c) = o; }
    LDS_WAIT(); asm volatile("" ::: "memory");
}
__device__ __forceinline__ void rms_row_to_bf16(int lane, const float* xrow, const float* g, bf16* orow) {
    const GAS f32x4* xr = (const GAS f32x4*)xrow + lane; const GAS f32x4* gr = (const GAS f32x4*)g + lane;
    f32x4 v[4]; float s = 0.f;
#pragma unroll
    for (int j = 0; j < 4; ++j) { v[j] = xr[64 * j]; s += (v[j].x * v[j].x + v[j].y * v[j].y) + (v[j].z * v[j].z + v[j].w * v[j].w); }
    const float inv = rsqrtf(wave_sum(s) * (1.f / D) + EPS);
    GAS unsigned long long* o8 = (GAS unsigned long long*)orow + lane;
#pragma unroll
    for (int j = 0; j < 4; ++j) { const f32x4 gg = gr[64 * j];
        o8[64 * j] = (unsigned long long)pk2(v[j].x * inv * gg.x, v[j].y * inv * gg.y) | ((unsigned long long)pk2(v[j].z * inv * gg.z, v[j].w * inv * gg.w) << 32); }
}
struct Args { const float* in[14]; float* out; unsigned char* ws; int ph_lo, ph_hi, coop, pad; };

__device__ __forceinline__ void p0_prologue(Frame& F, const Args& a) {
    LAS float* scr = (LAS float*)(F.lds + RING_OFF + F.wave * 16384);
    const int gw = F.vcu * NWAVES + F.wave, NGW = F.G * NWAVES;
    unsigned char* ws = a.ws;
    constexpr int I_IN = (D / 64) * (NPROJ / 32), I_O = (D / 64) * (D / 32), I_1 = (D / 64) * (FF / 32), I_2 = (FF / 64) * (D / 32);
    constexpr int NITEMS = I_IN + I_O + I_1 + I_2;
    for (int it = gw; it < NITEMS; it += NGW) {
        int r = it;
        if (r < I_IN) { p0_transpose_item(a.in[2], D, NPROJ, (bf16*)(ws + WS_WQKV), nullptr, scr, r, F.lane); continue; } r -= I_IN;
        if (r < I_O) { p0_transpose_item(a.in[9], D, D, (bf16*)(ws + WS_WO), nullptr, scr, r, F.lane); continue; } r -= I_O;
        if (r < I_1) { p0_transpose_item(a.in[11], D, FF, (bf16*)(ws + WS_W1), a.in[10], scr, r, F.lane); continue; } r -= I_1;
        p0_transpose_item(a.in[12], FF, D, (bf16*)(ws + WS_W2), nullptr, scr, r, F.lane);
    }
    for (int m = gw; m < M; m += NGW) rms_row_to_bf16(F.lane, a.in[0] + (size_t)m * D, a.in[1], (bf16*)(ws + WS_XN) + (size_t)m * D);
}
__device__ __forceinline__ void p6_final(Frame& F, const Args& a) {
    const int gw = F.vcu * NWAVES + F.wave, NGW = F.G * NWAVES;
    const float* ss2 = (const float*)(a.ws + WS_SS2); const GAS f32x4* gr = (const GAS f32x4*)a.in[13] + F.lane;
    f32x4 gg[4];
#pragma unroll
    for (int j = 0; j < 4; ++j) gg[j] = gr[64 * j];
    for (int m = gw; m < M; m += NGW) {
        const float inv = rsqrtf(__hip_atomic_load(ss2 + m, __ATOMIC_RELAXED, __HIP_MEMORY_SCOPE_AGENT) * (1.f / D) + EPS);
        GAS f32x4* o = (GAS f32x4*)(a.out + (size_t)m * D) + F.lane;
#pragma unroll
        for (int j = 0; j < 4; ++j) { f32x4 v = o[64 * j]; v = v * inv * gg[j]; o[64 * j] = v; }
    }
}
typedef unsigned u32x4g __attribute__((ext_vector_type(4)));
__device__ __forceinline__ float lam_of(const float* lq1, const float* lk1, const float* lq2, const float* lk2) {
    float s1 = 0.f, s2 = 0.f;
    for (int i = 0; i < 64; ++i) { s1 += lq1[i] * lk1[i]; s2 += lq2[i] * lk2[i]; }
    return __expf(s1) - __expf(s2) + 0.2f;
}
__device__ __forceinline__ void diff_scalar_unit(int unit, const bf16* proj, bf16* mix, float lam, const float* g) {
    const int tl = threadIdx.x >> 2, qr = threadIdx.x & 3;
    const int bh = unit >> 4, qb = ((unit & 15) + (unit >> 8) * 4) & 15, b = bh >> 2, h = bh & 3;
    const int t = qb * 128 + tl;
    const float slope = exp2f(-2.f * (float)(h + 1));
    const size_t rowb = (size_t)b * SEQ;
    unsigned q1[32], q2[32]; float a1[32], a2[32];
    { const u32x4g* qp = (const u32x4g*)(proj + (rowb + t) * NPROJ + C_DQ + h * 128);
#pragma unroll
      for (int i = 0; i < 8; ++i) { const u32x4g w = qp[i], w2 = qp[8 + i];
#pragma unroll
        for (int e = 0; e < 4; ++e) { q1[4 * i + e] = w[e]; q2[4 * i + e] = w2[e]; } } }
#pragma unroll
    for (int i = 0; i < 32; ++i) { a1[i] = 0.f; a2[i] = 0.f; }
    float m1 = -1e30f, l1 = 0.f, m2 = -1e30f, l2 = 0.f;
    for (int s = 0; s <= t; ++s) {
        const u32x4g* kp = (const u32x4g*)(proj + (rowb + s) * NPROJ + C_DK + h * 128);
        const u32x4g* vp = (const u32x4g*)(proj + (rowb + s) * NPROJ + C_DV + h * 128 + qr * 32);
        float d1 = 0.f, d2 = 0.f;
#pragma unroll
        for (int i = 0; i < 8; ++i) { const u32x4g w = kp[i], w2 = kp[8 + i];
#pragma unroll
            for (int e = 0; e < 4; ++e) { unsigned qa = q1[4 * i + e], qb_ = q2[4 * i + e]; asm volatile("" : "+v"(qa), "+v"(qb_));
                d1 += bflo(qa) * bflo(w[e]) + bfhi(qa) * bfhi(w[e]); d2 += bflo(qb_) * bflo(w2[e]) + bfhi(qb_) * bfhi(w2[e]); } }
        const float bias = -slope * (float)(t - s);
        d1 = d1 * 0.125f + bias; d2 = d2 * 0.125f + bias;
        const float mn1 = fmaxf(m1, d1), sc1 = __expf(m1 - mn1), p1 = __expf(d1 - mn1); l1 = l1 * sc1 + p1; m1 = mn1;
        const float mn2 = fmaxf(m2, d2), sc2 = __expf(m2 - mn2), p2 = __expf(d2 - mn2); l2 = l2 * sc2 + p2; m2 = mn2;
#pragma unroll
        for (int i = 0; i < 4; ++i) { const u32x4g w = vp[i];
#pragma unroll
            for (int e = 0; e < 4; ++e) { const float v0 = bflo(w[e]), v1 = bfhi(w[e]);
                a1[8 * i + 2 * e] = a1[8 * i + 2 * e] * sc1 + p1 * v0; a1[8 * i + 2 * e + 1] = a1[8 * i + 2 * e + 1] * sc1 + p1 * v1;
                a2[8 * i + 2 * e] = a2[8 * i + 2 * e] * sc2 + p2 * v0; a2[8 * i + 2 * e + 1] = a2[8 * i + 2 * e + 1] * sc2 + p2 * v1; } }
    }
    const float r1 = 1.f / l1, r2 = lam / l2; float ssq = 0.f;
#pragma unroll
    for (int i = 0; i < 32; ++i) { a1[i] = a1[i] * r1 - a2[i] * r2; ssq += a1[i] * a1[i]; }
    ssq += __shfl_xor(ssq, 1); ssq += __shfl_xor(ssq, 2);
    const float inv = rsqrtf(ssq * (1.f / 128.f) + EPS) * 0.8f;
    unsigned* op = (unsigned*)(mix + (rowb + t) * D + h * 128 + qr * 32);
#pragma unroll
    for (int i = 0; i < 16; ++i) op[i] = pk2(a1[2 * i] * inv * g[qr * 32 + 2 * i], a1[2 * i + 1] * inv * g[qr * 32 + 2 * i + 1]);
}
__device__ __forceinline__ void sb_scalar_unit(int unit, const bf16* proj, bf16* mix, const float* g) {
    const int qb = unit & 3, bh = unit >> 2, b = bh >> 3, h = bh & 7;
    const int t = qb * 512 + threadIdx.x;
    const size_t rowb = (size_t)b * SEQ;
    float q[64], acc[64];
    { const u32x4g* qp = (const u32x4g*)(proj + (rowb + t) * NPROJ + C_SQ + h * 64);
#pragma unroll
      for (int i = 0; i < 8; ++i) { const u32x4g w = qp[i];
#pragma unroll
        for (int e = 0; e < 4; ++e) { q[8 * i + 2 * e] = bflo(w[e]) * 0.125f; q[8 * i + 2 * e + 1] = bfhi(w[e]) * 0.125f; } } }
#pragma unroll
    for (int i = 0; i < 64; ++i) acc[i] = 0.f;
    float R = 0.f;
    for (int s = t - 1; s >= 0; --s) {
        const u32x4g* kp = (const u32x4g*)(proj + (rowb + s) * NPROJ + C_SK + h * 64);
        const u32x4g* vp = (const u32x4g*)(proj + (rowb + s) * NPROJ + C_SV + h * 64);
        float z = 0.f;
#pragma unroll
        for (int i = 0; i < 8; ++i) { const u32x4g w = kp[i];
#pragma unroll
            for (int e = 0; e < 4; ++e) z += q[8 * i + 2 * e] * bflo(w[e]) + q[8 * i + 2 * e + 1] * bfhi(w[e]); }
        const float ls = fminf(z, 0.f) - log1pf(__expf(-fabsf(z)));
        const float w_ = __expf(ls + R);
#pragma unroll
        for (int i = 0; i < 8; ++i) { const u32x4g w = vp[i];
#pragma unroll
            for (int e = 0; e < 4; ++e) { acc[8 * i + 2 * e] += w_ * bflo(w[e]); acc[8 * i + 2 * e + 1] += w_ * bfhi(w[e]); } }
        R += ls - z;
        if (R < -110.f) break;
    }
    float ssq = 0.f;
#pragma unroll
    for (int i = 0; i < 64; ++i) ssq += acc[i] * acc[i];
    const float inv = rsqrtf(ssq * (1.f / 64.f) + EPS);
    unsigned* op = (unsigned*)(mix + (rowb + t) * D + 512 + h * 64);
#pragma unroll
    for (int i = 0; i < 32; ++i) op[i] = pk2(acc[2 * i] * inv * g[2 * i], acc[2 * i + 1] * inv * g[2 * i + 1]);
}
__global__ void __launch_bounds__(NWAVES * 64, 2) fwd(Args args) {
    extern __shared__ __attribute__((aligned(16))) unsigned char lds[];
    Frame F;
    F.lds = (LAS unsigned char*)lds;
    F.tid = threadIdx.x; F.lane = F.tid & 63; F.wave = __builtin_amdgcn_readfirstlane(F.tid >> 6);
    F.G = gridDim.x; { const int bx = blockIdx.x; F.vcu = (F.G % 8 == 0) ? (bx % 8) * (F.G / 8) + bx / 8 : bx; }
    unsigned char* ws = args.ws;
    const int lo = args.ph_lo, hi = args.ph_hi;
#define IN(k) (lo <= (k) && (k) < hi)
#define SEAM(k) do { if (IN(k) && IN((k) + 1)) { cg::this_grid().sync(); } } while (0)
    if (IN(0)) { p0_prologue(F, args); } SEAM(0);
    if (IN(1)) {
        pg8::Gemm g{(const bf16*)(ws + WS_XN), (const bf16*)(ws + WS_WQKV), M, NPROJ, D}; pg8::StaticOrder S; S.init(M, NPROJ, F.G, (int)blockIdx.x);
        pg8::EpiBf16Plain E{(bf16*)(ws + WS_PROJ), NPROJ};
        pg8::gemm_phase<pg8::EpiBf16Plain, pg8::StaticOrder, PG8_ALIGN, PG8_SP2>(F.lds + RING_OFF, g, S, E);
    } SEAM(1);
    if (IN(2)) {
        const float lam = lam_of(args.in[3], args.in[4], args.in[5], args.in[6]);
        for (int u = blockIdx.x; u < BATCH * 4 * 16; u += F.G) diff_scalar_unit(u, (const bf16*)(ws + WS_PROJ), (bf16*)(ws + WS_MIX), lam, args.in[7]);
        for (int u = blockIdx.x; u < BATCH * 8 * 4; u += F.G) sb_scalar_unit(u, (const bf16*)(ws + WS_PROJ), (bf16*)(ws + WS_MIX), args.in[8]);
    }
    SEAM(2);
    if (IN(3)) {
        pg8::Gemm g{(const bf16*)(ws + WS_MIX), (const bf16*)(ws + WS_WO), M, D, D}; pg8::StaticOrder S; S.init(M, D, F.G, (int)blockIdx.x);
        pg8::EpiResid E{args.in[0], args.out, (bf16*)(ws + WS_XN), (float*)(ws + WS_SS1), D};
        pg8::gemm_phase<pg8::EpiResid, pg8::StaticOrder, PG8_ALIGN, PG8_SP2>(F.lds + RING_OFF, g, S, E);
    } SEAM(3);
    if (IN(4)) {
        pg8::Gemm g{(const bf16*)(ws + WS_XN), (const bf16*)(ws + WS_W1), M, FF, D}; pg8::StaticOrder S; S.init(M, FF, F.G, (int)blockIdx.x);
        pg8::EpiSqRelu E{(bf16*)(ws + WS_U), FF, (const float*)(ws + WS_SS1)};
        pg8::gemm_phase<pg8::EpiSqRelu, pg8::StaticOrder, PG8_ALIGN, PG8_SP2>(F.lds + RING_OFF, g, S, E);
    } SEAM(4);
    if (IN(5)) {
        pg8::Gemm g{(const bf16*)(ws + WS_U), (const bf16*)(ws + WS_W2), M, D, FF}; pg8::StaticOrder S; S.init(M, D, F.G, (int)blockIdx.x);
        pg8::EpiResid E{args.out, args.out, nullptr, (float*)(ws + WS_SS2), D};
        pg8::gemm_phase<pg8::EpiResid, pg8::StaticOrder, PG8_ALIGN, PG8_SP2>(F.lds + RING_OFF, g, S, E);
    } SEAM(5);
    if (IN(6)) { p6_final(F, args); }
#undef IN
#undef SEAM
}

extern "C" void kernel_launch(void* const* d_in, const int* in_sizes, int n_in, void* d_out, int out_size, void* d_ws, size_t ws_size, hipStream_t stream) {
    static int grid = 0;
    if (grid == 0) {
        if (n_in != 14 || in_sizes[0] != M * D || out_size != M * D || ws_size < WS_END) { fprintf(stderr, "kernel_launch: unexpected shapes (n_in %d, in0 %d, out %d, ws %zu)\n", n_in, n_in > 0 ? in_sizes[0] : -1, out_size, ws_size); grid = -1; return; }
        int dev = 0, cus = 0;
        if (hipGetDevice(&dev) != hipSuccess || hipDeviceGetAttribute(&cus, hipDeviceAttributeMultiprocessorCount, dev) != hipSuccess) { grid = -1; return; }
        if (hipFuncSetAttribute((const void*)fwd, hipFuncAttributeMaxDynamicSharedMemorySize, LDS_BYTES) != hipSuccess) { fprintf(stderr, "kernel_launch: hipFuncSetAttribute failed\n"); grid = -1; return; }
        grid = cus;
    }
    if (grid < 0) return;
    (void)hipMemsetAsync((char*)d_ws + WS_CTL, 0, CTL_ZERO_BYTES, stream);
    Args a{};
    for (int i = 0; i < 14; ++i) a.in[i] = (const float*)d_in[i];
    a.out = (float*)d_out; a.ws = (unsigned char*)d_ws; a.coop = 0; a.pad = 0;
    unsigned char* ws = (unsigned char*)d_ws;
    a.ph_lo = 0; a.ph_hi = 7; a.coop = 1;
    void* kargs[] = {&a};
    hipError_t e = hipLaunchCooperativeKernel((const void*)fwd, dim3(grid), dim3(NWAVES * 64), kargs, LDS_BYTES, stream);
    if (e != hipSuccess) fprintf(stderr, "kernel_launch: cooperative launch failed: %s (grid %d)\n", hipGetErrorString(e), grid);
}
```

```cpp
#include <hip/hip_runtime.h>
#include <hip/hip_cooperative_groups.h>
#include <cstdio>
#include <cstdint>
namespace cg = cooperative_groups;
namespace pg8 {
#define PG8_LAS __attribute__((address_space(3)))
typedef unsigned short bf16_t;
typedef short bf16x8 __attribute__((ext_vector_type(8)));
typedef float f32x4 __attribute__((ext_vector_type(4)));
typedef unsigned u32x4 __attribute__((ext_vector_type(4)));
constexpr int BM = 256, BK = 64, HALF = 128, HTB = HALF * BK * 2  , STAGE_BYTES = 8 * HTB, NXCD = 8, WGM = 8;

__host__ __device__ __forceinline__ int lds_byte(int r, int c) { const int st = (r >> 4) * 2 + (c >> 5), rr = r & 15, cc = c & 31, ob = rr * 64 + cc * 2; return st * 1024 + (ob ^ (((ob >> 9) & 1) << 5)); }
__host__ __device__ __forceinline__ void stage_rc(int b, int& R, int& C) { const int st = b / 1024, sb = b % 1024, swz = sb ^ (((sb >> 9) & 1) << 5); R = (st >> 1) * 16 + swz / 64; C = (st & 1) * 32 + (swz % 64) / 2; }
__host__ __device__ __forceinline__ int perm32(int rho) { const int n = rho >> 4, i = rho & 15; return 8 * (i >> 2) + 4 * n + (i & 3); }

struct Unit { int pm, pn; };
struct Gemm { const bf16_t* A; const bf16_t* Bt; int M, N, K; };

struct StaticOrder {
    int nM, nN, nwg, G, c;
    __host__ __device__ void init(int M, int N, int G_, int c_) { nM = M / BM; nN = N / BM; nwg = nM * nN; G = G_; c = c_; }
    __host__ __device__ bool next(int i, Unit& u) const {
        const long L = (long)i * G + c; if (L >= nwg) return false;
        int wgid = (int)L; { const int q = nwg / NXCD, r = nwg % NXCD, xcd = wgid % NXCD, off = wgid / NXCD; wgid = (xcd < r ? xcd * (q + 1) : r * (q + 1) + (xcd - r) * q) + off; }
        const int nig = WGM * nN, gid = wgid / nig, fm = gid * WGM, gsz = (nM - fm) < WGM ? (nM - fm) : WGM;
        u.pm = fm + ((wgid % nig) % gsz); u.pn = (wgid % nig) / gsz; return true;
    }
    __device__ __forceinline__ void a_ready(const Unit&) const {}
    __device__ __forceinline__ void done(const Unit&) const {}
};

__device__ __forceinline__ unsigned cvt_pk_bf16(float lo, float hi) { unsigned r; asm volatile("v_cvt_pk_bf16_f32 %0, %1, %2" : "=v"(r) : "v"(lo), "v"(hi)); return r; }
typedef unsigned u32x2 __attribute__((ext_vector_type(2)));
struct EpiBf16Plain {
    static constexpr bool PERM = true, AFTER_DRAIN = false;
    bf16_t* O; int ldc;
    __device__ __forceinline__ void operator()(const f32x4 (&acc)[2][2][4][2], const Unit& u, int wr, int wc, int fr, int fq) const {
        const int row0 = u.pm * BM + wr * 64 + fr; const int col0 = u.pn * BM + wc * 32 + 8 * fq;
#pragma unroll
        for (int ai = 0; ai < 2; ++ai)
#pragma unroll
            for (int m = 0; m < 4; ++m) { bf16_t* rowp = O + (size_t)(row0 + ai * HALF + m * 16) * ldc + col0;
#pragma unroll
                for (int bj = 0; bj < 2; ++bj) { const f32x4 v0 = acc[ai][bj][m][0], v1 = acc[ai][bj][m][1];
                    u32x4 w; w.x = cvt_pk_bf16(v0[0], v0[1]); w.y = cvt_pk_bf16(v0[2], v0[3]); w.z = cvt_pk_bf16(v1[0], v1[1]); w.w = cvt_pk_bf16(v1[2], v1[3]);
                    *(u32x4*)(rowp + bj * HALF) = w; } }
    }
};
struct EpiSqRelu {
    static constexpr bool PERM = true, AFTER_DRAIN = false;
    bf16_t* O; int ldc; const float* ss;
    __device__ __forceinline__ void operator()(const f32x4 (&acc)[2][2][4][2], const Unit& u, int wr, int wc, int fr, int fq) const {
        const int row0 = u.pm * BM + wr * 64 + fr; const int col0 = u.pn * BM + wc * 32 + 8 * fq;
#pragma unroll
        for (int ai = 0; ai < 2; ++ai)
#pragma unroll
            for (int m = 0; m < 4; ++m) { const int row = row0 + ai * HALF + m * 16; bf16_t* rowp = O + (size_t)row * ldc + col0;
                const float sv = __hip_atomic_load(ss + row, __ATOMIC_RELAXED, __HIP_MEMORY_SCOPE_AGENT);
                const float inv = rsqrtf(sv * (1.0f / 1024.0f) + 1e-6f), inv2 = inv * inv;
#pragma unroll
                for (int bj = 0; bj < 2; ++bj) { f32x4 v0 = acc[ai][bj][m][0], v1 = acc[ai][bj][m][1];
#pragma unroll
                    for (int e = 0; e < 4; ++e) { const float a = fmaxf(v0[e], 0.f), b = fmaxf(v1[e], 0.f); v0[e] = a * a * inv2; v1[e] = b * b * inv2; }
                    u32x4 w; w.x = cvt_pk_bf16(v0[0], v0[1]); w.y = cvt_pk_bf16(v0[2], v0[3]); w.z = cvt_pk_bf16(v1[0], v1[1]); w.w = cvt_pk_bf16(v1[2], v1[3]);
                    *(u32x4*)(rowp + bj * HALF) = w; } }
    }
};
struct EpiResid {
    static constexpr bool PERM = false, AFTER_DRAIN = false;
    const float* base; float* out; bf16_t* ob; float* ss; int ldc;
    __device__ __forceinline__ void operator()(const f32x4 (&acc)[2][2][4][2], const Unit& u, int wr, int wc, int fr, int fq) const {
        const int col0 = u.pn * BM + wc * 32 + 4 * fq;
#pragma unroll
        for (int ai = 0; ai < 2; ++ai)
#pragma unroll
            for (int m = 0; m < 4; ++m) { const int r = u.pm * BM + ai * HALF + wr * 64 + m * 16 + fr; const size_t off = (size_t)r * ldc + col0; float s = 0.f;
#pragma unroll
                for (int bj = 0; bj < 2; ++bj)
#pragma unroll
                    for (int n = 0; n < 2; ++n) { const f32x4 bs = *(const f32x4*)(base + off + bj * HALF + n * 16); const f32x4 o = bs + acc[ai][bj][m][n];
                        *(f32x4*)(out + off + bj * HALF + n * 16) = o; s += (o[0] * o[0] + o[1] * o[1]) + (o[2] * o[2] + o[3] * o[3]);
                        if (ob) { u32x2 w; w.x = cvt_pk_bf16(o[0], o[1]); w.y = cvt_pk_bf16(o[2], o[3]); *(u32x2*)(ob + off + bj * HALF + n * 16) = w; } }
                s += __shfl_xor(s, 16); s += __shfl_xor(s, 32);
                if (fq == 0) (void)__hip_atomic_fetch_add(ss + r, s, __ATOMIC_RELAXED, __HIP_MEMORY_SCOPE_AGENT); }
    }
};

template <class Epi, class Sched, bool ALIGN_EPI = false, bool SP2 = false>
__device__ __forceinline__ void gemm_phase(PG8_LAS unsigned char* lds, const Gemm g, const Sched& S, const Epi& E) {
    const int tid = threadIdx.x, wid = __builtin_amdgcn_readfirstlane(tid >> 6), lane = tid & 63, wr = wid >> 2, wc = wid & 3, fr = lane & 15, fq = lane >> 4;
    const int K = g.K, nt = K / BK;
    unsigned voffA[2], voffB[2];
#pragma unroll
    for (int i = 0; i < 2; ++i) { int R, C; stage_rc(tid * 16 + i * 8192, R, C); const int Rb = Epi::PERM ? ((R & ~31) + perm32(R & 31)) : R;
        voffA[i] = (unsigned)(R * K + C) * 2u; voffB[i] = (unsigned)(Rb * K + C) * 2u; }
    const size_t kstep = (size_t)(BK * 2);
    const size_t hstep = (size_t)HALF * K * 2;
    const size_t tstep = 2 * hstep;
    const unsigned ldsw = (unsigned)wid * 1024u;
    const int aoff = lds_byte(wr * 64 + fr, fq * 8), boff = lds_byte(wc * 32 + fr, fq * 8);
#define PG8_SA(b, h) (((b) * 2 + (h)) * HTB)
#define PG8_SB(b, h) ((4 + (b) * 2 + (h)) * HTB)
#define PG8_STAGE(bufoff, gbase, voff) do { _Pragma("unroll") for (int _i = 0; _i < 2; ++_i) \
        __builtin_amdgcn_global_load_lds((const unsigned*)((const char*)(gbase) + (voff)[_i]), (PG8_LAS unsigned*)(lds + (bufoff) + ldsw + _i * 8192), 16, 0, 0); } while (0)
#define PG8_LDA(dst, b, h) do { _Pragma("unroll") for (int m = 0; m < 4; ++m) _Pragma("unroll") for (int k = 0; k < 2; ++k) dst[m][k] = *(const PG8_LAS bf16x8*)(lds + PG8_SA(b, h) + aoff + m * 2048 + k * 1024); } while (0)
#define PG8_LDB(dst, b, h) do { _Pragma("unroll") for (int n = 0; n < 2; ++n) _Pragma("unroll") for (int k = 0; k < 2; ++k) dst[n][k] = *(const PG8_LAS bf16x8*)(lds + PG8_SB(b, h) + boff + n * 2048 + k * 1024); } while (0)
#define PG8_MMA(ai, bj, At, Bt) do { __builtin_amdgcn_s_setprio(1); _Pragma("unroll") for (int m = 0; m < 4; ++m) _Pragma("unroll") for (int n = 0; n < 2; ++n) _Pragma("unroll") for (int k = 0; k < 2; ++k) \
        acc[ai][bj][m][n] = __builtin_amdgcn_mfma_f32_16x16x32_bf16(Bt[n][k], At[m][k], acc[ai][bj][m][n], 0, 0, 0); __builtin_amdgcn_s_setprio(0); } while (0)
#define PG8_WAIT_V(n) asm volatile("s_waitcnt vmcnt(" #n ")" ::: "memory")
#define PG8_WAIT_L(n) asm volatile("s_waitcnt lgkmcnt(" #n ")" ::: "memory")
#define PG8_BAR __builtin_amdgcn_s_barrier()
#define PG8_SCHED __builtin_amdgcn_sched_barrier(0)
    Unit cur, nxt; int ui = 0;
    if (!S.next(0, cur)) return;
    f32x4 acc[2][2][4][2];
#pragma unroll
    for (int a = 0; a < 2; ++a)
#pragma unroll
        for (int b = 0; b < 2; ++b)
#pragma unroll
            for (int m = 0; m < 4; ++m)
#pragma unroll
                for (int n = 0; n < 2; ++n) acc[a][b][m][n] = (f32x4){0.f, 0.f, 0.f, 0.f};
    bf16x8 At[4][2], B0[2][2], B1[2][2];
    const char* cA = (const char*)g.A + (size_t)cur.pm * tstep; const char* cB = (const char*)g.Bt + (size_t)cur.pn * tstep;
    S.a_ready(cur);
    if constexpr (SP2) {
        PG8_STAGE(PG8_SB(0, 0), cB, voffB); PG8_STAGE(PG8_SB(0, 1), cB + hstep, voffB); PG8_STAGE(PG8_SA(0, 0), cA, voffA); PG8_STAGE(PG8_SA(0, 1), cA + hstep, voffA);
        if (wr == 1) PG8_BAR;
        PG8_WAIT_V(2); PG8_BAR;
        PG8_STAGE(PG8_SB(1, 0), cB + kstep, voffB); PG8_STAGE(PG8_SA(1, 0), cA + kstep, voffA); PG8_STAGE(PG8_SB(1, 1), cB + hstep + kstep, voffB);
        PG8_WAIT_V(6); PG8_BAR;
    } else {
        PG8_STAGE(PG8_SB(0, 0), cB, voffB); PG8_STAGE(PG8_SA(0, 0), cA, voffA); PG8_STAGE(PG8_SB(0, 1), cB + hstep, voffB); PG8_STAGE(PG8_SA(0, 1), cA + hstep, voffA);
        if (wr == 1) PG8_BAR;
        PG8_WAIT_V(4); PG8_BAR;
        PG8_STAGE(PG8_SB(1, 0), cB + kstep, voffB); PG8_STAGE(PG8_SA(1, 0), cA + kstep, voffA); PG8_STAGE(PG8_SB(1, 1), cB + hstep + kstep, voffB);
        PG8_WAIT_V(6); PG8_BAR;
    }
    for (;;) {
        const bool has_next = S.next(ui + 1, nxt);
        const char* nA = has_next ? (const char*)g.A + (size_t)nxt.pm * tstep : cA; const char* nB = has_next ? (const char*)g.Bt + (size_t)nxt.pn * tstep : cB;
        for (int t = 0; t < nt; t += 2) {
            const bool last = (t == nt - 2);
            const char* a1 = cA + (size_t)(t + 1) * kstep;
            const char* a2 = last ? nA : cA + (size_t)(t + 2) * kstep; const char* b2 = last ? nB : cB + (size_t)(t + 2) * kstep;
            const char* a3 = a2 + kstep; const char* b3 = b2 + kstep;
            if (last && has_next) S.a_ready(nxt);
            if constexpr (SP2) {
            PG8_LDB(B0, 0, 0); PG8_LDB(B1, 0, 1); PG8_SCHED; PG8_LDA(At, 0, 0); PG8_STAGE(PG8_SA(1, 1), a1 + hstep, voffA);
            PG8_WAIT_V(8); PG8_WAIT_L(0); PG8_BAR; PG8_MMA(0, 0, At, B0); PG8_MMA(0, 1, At, B1); PG8_BAR; PG8_SCHED;
            PG8_LDA(At, 0, 1); PG8_STAGE(PG8_SB(0, 0), b2, voffB); PG8_STAGE(PG8_SB(0, 1), b2 + hstep, voffB); PG8_STAGE(PG8_SA(0, 0), a2, voffA);
            PG8_WAIT_V(8); PG8_WAIT_L(0); PG8_BAR; PG8_MMA(1, 0, At, B0); PG8_MMA(1, 1, At, B1); PG8_BAR; PG8_SCHED;
            PG8_LDB(B0, 1, 0); PG8_LDB(B1, 1, 1); PG8_SCHED; PG8_LDA(At, 1, 0); PG8_STAGE(PG8_SA(0, 1), a2 + hstep, voffA);
            PG8_WAIT_V(8); PG8_WAIT_L(0); PG8_BAR; PG8_MMA(0, 0, At, B0); PG8_MMA(0, 1, At, B1); PG8_BAR; PG8_SCHED;
            PG8_LDA(At, 1, 1); PG8_STAGE(PG8_SB(1, 0), b3, voffB); PG8_STAGE(PG8_SB(1, 1), b3 + hstep, voffB); PG8_STAGE(PG8_SA(1, 0), a3, voffA);
            PG8_WAIT_V(8); PG8_WAIT_L(0); PG8_BAR; PG8_MMA(1, 0, At, B0); PG8_MMA(1, 1, At, B1); PG8_BAR; PG8_SCHED;
            } else {
            PG8_LDB(B0, 0, 0); PG8_SCHED; PG8_LDA(At, 0, 0); PG8_STAGE(PG8_SA(1, 1), a1 + hstep, voffA);
            PG8_WAIT_L(8); PG8_BAR; PG8_WAIT_L(0); PG8_MMA(0, 0, At, B0); PG8_BAR; PG8_SCHED;
            PG8_LDB(B1, 0, 1); PG8_STAGE(PG8_SB(0, 0), b2, voffB);
            PG8_BAR; PG8_WAIT_L(0); PG8_MMA(0, 1, At, B1); PG8_BAR;
            PG8_LDA(At, 0, 1); PG8_STAGE(PG8_SA(0, 0), a2, voffA);
            PG8_BAR; PG8_WAIT_L(0); PG8_MMA(1, 0, At, B0); PG8_BAR; PG8_SCHED;
            PG8_STAGE(PG8_SB(0, 1), b2 + hstep, voffB);
            PG8_WAIT_V(6); PG8_BAR; PG8_MMA(1, 1, At, B1); PG8_BAR;
            PG8_LDB(B0, 1, 0); PG8_SCHED; PG8_LDA(At, 1, 0); PG8_STAGE(PG8_SA(0, 1), a2 + hstep, voffA);
            PG8_WAIT_L(8); PG8_BAR; PG8_WAIT_L(0); PG8_MMA(0, 0, At, B0); PG8_BAR; PG8_SCHED;
            PG8_LDB(B1, 1, 1); PG8_STAGE(PG8_SB(1, 0), b3, voffB);
            PG8_BAR; PG8_WAIT_L(0); PG8_MMA(0, 1, At, B1); PG8_BAR;
            PG8_LDA(At, 1, 1); PG8_STAGE(PG8_SA(1, 0), a3, voffA);
            PG8_BAR; PG8_WAIT_L(0); PG8_MMA(1, 0, At, B0); PG8_BAR; PG8_SCHED;
            PG8_STAGE(PG8_SB(1, 1), b3 + hstep, voffB);
            PG8_WAIT_V(6); PG8_BAR; PG8_MMA(1, 1, At, B1); PG8_BAR;
            }
        }
        if constexpr (ALIGN_EPI) { if (wr == 0) PG8_BAR; }
        if constexpr (!Epi::AFTER_DRAIN) { E(acc, cur, wr, wc, fr, fq); S.done(cur); }
        if (!has_next) break;
#pragma unroll
        for (int a = 0; a < 2; ++a)
#pragma unroll
            for (int b = 0; b < 2; ++b)
#pragma unroll
                for (int m = 0; m < 4; ++m)
#pragma unroll
                    for (int n = 0; n < 2; ++n) acc[a][b][m][n] = (f32x4){0.f, 0.f, 0.f, 0.f};
        cur = nxt; cA = nA; cB = nB; ++ui;
        if constexpr (ALIGN_EPI) { if (wr == 1) PG8_BAR; }
    }
    PG8_WAIT_V(0);
    if constexpr (!ALIGN_EPI) { if (wr == 0) PG8_BAR; }
    PG8_BAR;
    if constexpr (Epi::AFTER_DRAIN) { E.fused(acc, cur, wr, wc, fr, fq, lds, wid, lane); S.done(cur); }
#undef PG8_SA
#undef PG8_SB
#undef PG8_STAGE
#undef PG8_LDA
#undef PG8_LDB
#undef PG8_MMA
#undef PG8_WAIT_V
#undef PG8_WAIT_L
#undef PG8_BAR
#undef PG8_SCHED
}
}
#ifndef PG8_SP2
#define PG8_SP2 true
#endif
#ifndef PG8_ALIGN
#define PG8_ALIGN true
#endif
constexpr int NWAVES = 8;
constexpr int BATCH = 16, SEQ = 2048, D = 1024, FF = 4096, NPROJ = 3072;
constexpr int M = BATCH * SEQ;
constexpr float EPS = 1e-6f;
constexpr int C_DQ = 0, C_DK = 512, C_DV = 1024, C_SQ = 1536, C_SK = 2048, C_SV = 2560;
constexpr size_t MiB = 1u << 20;
constexpr size_t WS_CTL = 0, CTL_ZERO_BYTES = 1 * MiB;
constexpr size_t WS_SS1 = 0, WS_SS2 = 256 * 1024;
constexpr size_t WS_WQKV = 2 * MiB, WS_WO = 8 * MiB, WS_W1 = 10 * MiB, WS_W2 = 18 * MiB;
constexpr size_t WS_XN = 32 * MiB;
constexpr size_t WS_PROJ = 96 * MiB;
constexpr size_t WS_MIX = 288 * MiB;
constexpr size_t WS_U = 96 * MiB;
constexpr size_t WS_END = 352 * MiB;
constexpr int RING_OFF = 0, RING_BYTES = 131072;
constexpr int LDS_BYTES = 147456;

#define GAS __attribute__((address_space(1)))
#define LAS __attribute__((address_space(3)))
typedef unsigned short bf16;
typedef unsigned v4u __attribute__((ext_vector_type(4)));
typedef float f32x4 __attribute__((ext_vector_type(4)));
#define LDS_WAIT() asm volatile("s_waitcnt lgkmcnt(0)" ::: "memory")
__device__ __forceinline__ unsigned f2bf(float f) { unsigned u = __builtin_bit_cast(unsigned, f); return (u + 0x7fffu + ((u >> 16) & 1u)) >> 16; }
__device__ __forceinline__ unsigned pk2(float lo, float hi) { return f2bf(lo) | (f2bf(hi) << 16); }
__device__ __forceinline__ float bflo(unsigned w) { return __builtin_bit_cast(float, w << 16); }
__device__ __forceinline__ float bfhi(unsigned w) { return __builtin_bit_cast(float, w & 0xffff0000u); }

struct Frame {
    LAS unsigned char* lds;
    int tid, lane, wave, vcu, G;
};
__device__ __forceinline__ float wave_sum(float v) {
#pragma unroll
    for (int o = 1; o < 64; o <<= 1) v += __shfl_xor(v, o);
    return v;
}
__device__ __forceinline__ void p0_transpose_item(const float* W, int K, int N, bf16* WT, const float* ks, LAS float* scr, int item, int lane) {
    const int nblk = N / 32, kb = item / nblk, nb = item % nblk, k0 = 64 * kb, n0 = 32 * nb;
#pragma unroll 8
    for (int i = 0; i < 32; ++i) { const int kk = 2 * i + (lane >> 5); float v = W[(size_t)(k0 + kk) * N + n0 + (lane & 31)]; if (ks) v *= ks[k0 + kk]; scr[kk * 33 + (lane & 31)] = v; }
    LDS_WAIT(); asm volatile("" ::: "memory");
    const int c = lane & 7;
#pragma unroll
    for (int j = 0; j < 4; ++j) { const int n = (lane >> 3) + 8 * j; const LAS float* s = scr + (8 * c) * 33 + n;
        v4u o; o.x = pk2(s[0 * 33], s[1 * 33]); o.y = pk2(s[2 * 33], s[3 * 33]); o.z = pk2(s[4 * 33], s[5 * 33]); o.w = pk2(s[6 * 33], s[7 * 33]);
        *(GAS v4u*)(WT + (size_t)(n0 + n) * K + k0 + 8 * c) = o; }
    LDS_WAIT(); asm volatile("" ::: "memory");
}
__device__ __forceinline__ void rms_row_to_bf16(int lane, const float* xrow, const float* g, bf16* orow) {
    const GAS f32x4* xr = (const GAS f32x4*)xrow + lane; const GAS f32x4* gr = (const GAS f32x4*)g + lane;
    f32x4 v[4]; float s = 0.f;
#pragma unroll
    for (int j = 0; j < 4; ++j) { v[j] = xr[64 * j]; s += (v[j].x * v[j].x + v[j].y * v[j].y) + (v[j].z * v[j].z + v[j].w * v[j].w); }
    const float inv = rsqrtf(wave_sum(s) * (1.f / D) + EPS);
    GAS unsigned long long* o8 = (GAS unsigned long long*)orow + lane;
#pragma unroll
    for (int j = 0; j < 4; ++j) { const f32x4 gg = gr[64 * j];
        o8[64 * j] = (unsigned long long)pk2(v[j].x * inv * gg.x, v[j].y * inv * gg.y) | ((unsigned long long)pk2(v[j].z * inv * gg.z, v[j].w * inv * gg.w) << 32); }
}
struct Args { const float* in[14]; float* out; unsigned char* ws; int ph_lo, ph_hi, coop, pad; };

__device__ __forceinline__ void p0_prologue(Frame& F, const Args& a) {
    LAS float* scr = (LAS float*)(F.lds + RING_OFF + F.wave * 16384);
    const int gw = F.vcu * NWAVES + F.wave, NGW = F.G * NWAVES;
    unsigned char* ws = a.ws;
    constexpr int I_IN = (D / 64) * (NPROJ / 32), I_O = (D / 64) * (D / 32), I_1 = (D / 64) * (FF / 32), I_2 = (FF / 64) * (D / 32);
    constexpr int NITEMS = I_IN + I_O + I_1 + I_2;
    for (int it = gw; it < NITEMS; it += NGW) {
        int r = it;
        if (r < I_IN) { p0_transpose_item(a.in[2], D, NPROJ, (bf16*)(ws + WS_WQKV), nullptr, scr, r, F.lane); continue; } r -= I_IN;
        if (r < I_O) { p0_transpose_item(a.in[9], D, D, (bf16*)(ws + WS_WO), nullptr, scr, r, F.lane); continue; } r -= I_O;
        if (r < I_1) { p0_transpose_item(a.in[11], D, FF, (bf16*)(ws + WS_W1), a.in[10], scr, r, F.lane); continue; } r -= I_1;
        p0_transpose_item(a.in[12], FF, D, (bf16*)(ws + WS_W2), nullptr, scr, r, F.lane);
    }
    for (int m = gw; m < M; m += NGW) rms_row_to_bf16(F.lane, a.in[0] + (size_t)m * D, a.in[1], (bf16*)(ws + WS_XN) + (size_t)m * D);
}
__device__ __forceinline__ void p6_final(Frame& F, const Args& a) {
    const int gw = F.vcu * NWAVES + F.wave, NGW = F.G * NWAVES;
    const float* ss2 = (const float*)(a.ws + WS_SS2); const GAS f32x4* gr = (const GAS f32x4*)a.in[13] + F.lane;
    f32x4 gg[4];
#pragma unroll
    for (int j = 0; j < 4; ++j) gg[j] = gr[64 * j];
    for (int m = gw; m < M; m += NGW) {
        const float inv = rsqrtf(__hip_atomic_load(ss2 + m, __ATOMIC_RELAXED, __HIP_MEMORY_SCOPE_AGENT) * (1.f / D) + EPS);
        GAS f32x4* o = (GAS f32x4*)(a.out + (size_t)m * D) + F.lane;
#pragma unroll
        for (int j = 0; j < 4; ++j) { f32x4 v = o[64 * j]; v = v * inv * gg[j]; o[64 * j] = v; }
    }
}
typedef unsigned u32x4g __attribute__((ext_vector_type(4)));
__device__ __forceinline__ float lam_of(const float* lq1, const float* lk1, const float* lq2, const float* lk2) {
    float s1 = 0.f, s2 = 0.f;
    for (int i = 0; i < 64; ++i) { s1 += lq1[i] * lk1[i]; s2 += lq2[i] * lk2[i]; }
    return __expf(s1) - __expf(s2) + 0.2f;
}
namespace mixer {
typedef short bf16x8 __attribute__((ext_vector_type(8)));
typedef short s16x4 __attribute__((ext_vector_type(4)));
typedef short v4i16_t __attribute__((ext_vector_type(4)));
typedef float f32x16 __attribute__((ext_vector_type(16)));
typedef unsigned u32x4 __attribute__((ext_vector_type(4)));
typedef unsigned u32x2 __attribute__((ext_vector_type(2)));
typedef float f32x2_t __attribute__((ext_vector_type(2))); typedef __bf16 bf16x2_t __attribute__((ext_vector_type(2)));
constexpr int KSTR = 144, KBUF = 64 * KSTR;
constexpr int VSTRD = 320, VBUFD = 64 * VSTRD;
constexpr int VSTRS = 192, VBUFS = 64 * VSTRS;
constexpr int OFF_K = 0, OFF_V = 2 * KBUF, OFF_CNT = OFF_V + 2 * VBUFD, OFF_O1 = OFF_CNT + 128;
static_assert(OFF_O1 + 65536 <= RING_BYTES, "mixer LDS map");
constexpr float LOG2E = 1.4426950408889634f, LN2 = 0.6931471805599453f;
__device__ __forceinline__ s16x4 vtr(const LAS unsigned char* p) { return __builtin_bit_cast(s16x4, __builtin_amdgcn_ds_read_tr16_b64_v4i16((LAS v4i16_t*)p)); }
__device__ __forceinline__ unsigned cvtpk(float lo, float hi) { f32x2_t v = {lo, hi}; bf16x2_t b = __builtin_convertvector(v, bf16x2_t); return __builtin_bit_cast(unsigned, b); }
__device__ __forceinline__ float xhalf(float v) { return __shfl_xor(v, 32); }
#define CROW(r) (((r) & 3) + 8 * ((r) >> 2))
__device__ __forceinline__ void qk_tile(f32x16& p0, f32x16& p1, const LAS unsigned char* Kt, const bf16x8 (&qr)[4], int r32, int hi) {
    const LAS unsigned char* kb = Kt + r32 * KSTR + hi * 16;
#pragma unroll
    for (int r = 0; r < 16; ++r) { p0[r] = 0.f; p1[r] = 0.f; }
#pragma unroll
    for (int d0 = 0; d0 < 4; ++d0) {
        const bf16x8 a0 = *(const LAS bf16x8*)(kb + d0 * 32), a1 = *(const LAS bf16x8*)(kb + 32 * KSTR + d0 * 32);
        p0 = __builtin_amdgcn_mfma_f32_32x32x16_bf16(a0, qr[d0], p0, 0, 0, 0); p1 = __builtin_amdgcn_mfma_f32_32x32x16_bf16(a1, qr[d0], p1, 0, 0, 0); }
}
template <int NB, int VSTR> __device__ __forceinline__ void pv_tile(f32x16 (&o)[NB], const LAS unsigned char* vb, const f32x16& p0, const f32x16& p1) {
    u32x4 pw[4];
#pragma unroll
    for (int e = 0; e < 4; ++e) { pw[0][e] = cvtpk(p0[2 * e], p0[2 * e + 1]); pw[1][e] = cvtpk(p0[8 + 2 * e], p0[9 + 2 * e]); pw[2][e] = cvtpk(p1[2 * e], p1[2 * e + 1]); pw[3][e] = cvtpk(p1[8 + 2 * e], p1[9 + 2 * e]); }
#pragma unroll
    for (int ks = 0; ks < 4; ++ks)
#pragma unroll
        for (int nb = 0; nb < NB; ++nb) {
            const s16x4 lo = vtr(vb + (ks * 16) * VSTR + nb * 64), hh = vtr(vb + (ks * 16 + 8) * VSTR + nb * 64);
            const bf16x8 vf = {lo[0], lo[1], lo[2], lo[3], hh[0], hh[1], hh[2], hh[3]};
            o[nb] = __builtin_amdgcn_mfma_f32_32x32x16_bf16(vf, __builtin_bit_cast(bf16x8, pw[ks]), o[nb], 0, 0, 0); }
}
__device__ __forceinline__ void diff_unit(LAS unsigned char* lds, const bf16* proj, bf16* mixo, int b, int h, int qb, float lam, const float* g) {
    const int tid = threadIdx.x, lane = tid & 63, r32 = lane & 31, hi = lane >> 5, wid = __builtin_amdgcn_readfirstlane(tid >> 6);
    const size_t rowb = (size_t)b * SEQ; const int q0 = qb * 256, qw0 = q0 + wid * 32, qpos = qw0 + r32, NT = (q0 + 256) / 64;
    const float slope2 = exp2f(-2.f * (float)(h + 1)) * LOG2E, C2 = 0.125f * LOG2E;
    const int krow = tid >> 3, kch = tid & 7, vrow = tid >> 4, vch = tid & 15;
    const int vlane = (4 * (lane >> 5) + ((lane & 15) >> 2)) * VSTRD + (16 * ((lane >> 4) & 1) + 4 * (lane & 3)) * 2;
    LAS unsigned* o1s = (LAS unsigned*)(lds + OFF_O1) + wid * 2048 + lane;
    f32x16 o[4];
    for (int map = 0; map < 2; ++map) {
        const bf16* Qp = proj + (rowb + qpos) * NPROJ + C_DQ + h * 128 + map * 64;
        const bf16* Kb = proj + rowb * NPROJ + C_DK + h * 128 + map * 64 + (size_t)krow * NPROJ + kch * 8;
        const bf16* Vb = proj + rowb * NPROJ + C_DV + h * 128 + (size_t)vrow * NPROJ + vch * 8;
        bf16x8 qr[4];
#pragma unroll
        for (int d0 = 0; d0 < 4; ++d0) qr[d0] = *(const bf16x8*)(Qp + 16 * d0 + 8 * hi);
#pragma unroll
        for (int nb = 0; nb < 4; ++nb)
#pragma unroll
            for (int r = 0; r < 16; ++r) o[nb][r] = 0.f;
        float mref = -1e30f, l = 0.f;
        u32x4 kreg = *(const u32x4*)(Kb), vreg0 = *(const u32x4*)(Vb), vreg1 = *(const u32x4*)(Vb + (size_t)32 * NPROJ);
        __syncthreads();
        *(LAS u32x4*)(lds + OFF_K + krow * KSTR + kch * 16) = kreg; *(LAS u32x4*)(lds + OFF_V + vrow * VSTRD + vch * 16) = vreg0; *(LAS u32x4*)(lds + OFF_V + (vrow + 32) * VSTRD + vch * 16) = vreg1;
        __syncthreads();
        for (int t = 0; t < NT; ++t) {
            const int buf = t & 1;
            if (t + 1 < NT) { const size_t go = (size_t)(64 * (t + 1)) * NPROJ; kreg = *(const u32x4*)(Kb + go); vreg0 = *(const u32x4*)(Vb + go); vreg1 = *(const u32x4*)(Vb + go + (size_t)32 * NPROJ); }
            if (64 * t <= qw0) {
                f32x16 p0, p1;
                qk_tile(p0, p1, lds + OFF_K + buf * KBUF, qr, r32, hi);
                const int di = qpos - 64 * t - 4 * hi; const float bb = -slope2 * (float)di;
                const bool diag = (64 * t + 63 > qw0);
                float rm = -INFINITY;
#pragma unroll
                for (int r = 0; r < 16; ++r) {
                    p0[r] = __builtin_fmaf(p0[r], C2, __builtin_fmaf(slope2, (float)CROW(r), bb)); p1[r] = __builtin_fmaf(p1[r], C2, __builtin_fmaf(slope2, (float)(CROW(r) + 32), bb));
                    if (diag) { if (CROW(r) > di) p0[r] = -INFINITY; if (CROW(r) + 32 > di) p1[r] = -INFINITY; }
                    rm = fmaxf(rm, fmaxf(p0[r], p1[r])); }
                rm = fmaxf(rm, xhalf(rm));
                if (__any(rm > mref + 8.f)) {
                    const float mn = fmaxf(mref, rm), al = __builtin_amdgcn_exp2f(mref - mn); mref = mn; l *= al;
#pragma unroll
                    for (int nb = 0; nb < 4; ++nb)
#pragma unroll
                        for (int r = 0; r < 16; ++r) o[nb][r] *= al; }
                float ps = 0.f;
#pragma unroll
                for (int r = 0; r < 16; ++r) { p0[r] = __builtin_amdgcn_exp2f(p0[r] - mref); p1[r] = __builtin_amdgcn_exp2f(p1[r] - mref); ps += p0[r] + p1[r]; }
                l += ps;
                pv_tile<4, VSTRD>(o, lds + OFF_V + buf * VBUFD + vlane, p0, p1);
            }
            if (t + 1 < NT) { const int nb_ = buf ^ 1; *(LAS u32x4*)(lds + OFF_K + nb_ * KBUF + krow * KSTR + kch * 16) = kreg;
                *(LAS u32x4*)(lds + OFF_V + nb_ * VBUFD + vrow * VSTRD + vch * 16) = vreg0; *(LAS u32x4*)(lds + OFF_V + nb_ * VBUFD + (vrow + 32) * VSTRD + vch * 16) = vreg1; }
            __syncthreads();
        }
        const float lt = l + xhalf(l);
        if (map == 0) { const float rl = 1.f / lt;
#pragma unroll
            for (int nb = 0; nb < 4; ++nb)
#pragma unroll
                for (int k = 0; k < 8; ++k) o1s[(nb * 8 + k) * 64] = cvtpk(o[nb][2 * k] * rl, o[nb][2 * k + 1] * rl);
        } else { const float rl2 = lam / lt; float ssq = 0.f;
#pragma unroll
            for (int nb = 0; nb < 4; ++nb)
#pragma unroll
                for (int k = 0; k < 8; ++k) { const unsigned ow = o1s[(nb * 8 + k) * 64]; const float a = bflo(ow) - o[nb][2 * k] * rl2, c = bfhi(ow) - o[nb][2 * k + 1] * rl2; o[nb][2 * k] = a; o[nb][2 * k + 1] = c; ssq += a * a + c * c; }
            ssq += xhalf(ssq);
            const float inv = rsqrtf(ssq * (1.f / 128.f) + EPS) * 0.8f;
            bf16* orow = mixo + (rowb + qpos) * D + h * 128 + 4 * hi;
#pragma unroll
            for (int nb = 0; nb < 4; ++nb)
#pragma unroll
                for (int gq = 0; gq < 4; ++gq) { const int d = 32 * nb + 8 * gq; const f32x4 gv = *(const f32x4*)(g + d + 4 * hi);
                    u32x2 w; w.x = cvtpk(o[nb][4 * gq] * inv * gv[0], o[nb][4 * gq + 1] * inv * gv[1]); w.y = cvtpk(o[nb][4 * gq + 2] * inv * gv[2], o[nb][4 * gq + 3] * inv * gv[3]);
                    *(u32x2*)(orow + d) = w; }
        }
    }
}
__device__ __forceinline__ void sb_unit(LAS unsigned char* lds, const bf16* proj, bf16* mixo, int b, int h, int qb, const float* g) {
    const int tid = threadIdx.x, lane = tid & 63, r32 = lane & 31, hi = lane >> 5, wid = __builtin_amdgcn_readfirstlane(tid >> 6);
    const size_t rowb = (size_t)b * SEQ; const int q0 = qb * 256, qw0 = q0 + wid * 32, qpos = qw0 + r32, NT = (q0 + 256) / 64;
    const int krow = tid >> 3, kch = tid & 7;
    const int vlane = (4 * (lane >> 5) + ((lane & 15) >> 2)) * VSTRS + (16 * ((lane >> 4) & 1) + 4 * (lane & 3)) * 2;
    LAS int* cnt = (LAS int*)(lds + OFF_CNT);
    const bf16* Qp = proj + (rowb + qpos) * NPROJ + C_SQ + h * 64;
    const bf16* Kb = proj + rowb * NPROJ + C_SK + h * 64 + (size_t)krow * NPROJ + kch * 8;
    const bf16* Vb = proj + rowb * NPROJ + C_SV + h * 64 + (size_t)krow * NPROJ + kch * 8;
    bf16x8 qr[4];
#pragma unroll
    for (int d0 = 0; d0 < 4; ++d0) qr[d0] = *(const bf16x8*)(Qp + 16 * d0 + 8 * hi);
    f32x16 o[2];
#pragma unroll
    for (int nb = 0; nb < 2; ++nb)
#pragma unroll
        for (int r = 0; r < 16; ++r) o[nb][r] = 0.f;
    float R = 0.f; bool done = false;
    { const size_t go = (size_t)(64 * (NT - 1)) * NPROJ; u32x4 kreg = *(const u32x4*)(Kb + go), vreg = *(const u32x4*)(Vb + go);
      __syncthreads();
      if (tid < 32) cnt[tid] = 0;
      *(LAS u32x4*)(lds + OFF_K + krow * KSTR + kch * 16) = kreg; *(LAS u32x4*)(lds + OFF_V + krow * VSTRS + kch * 16) = vreg;
      __syncthreads(); }
    for (int it = 0; it < NT; ++it) {
        const int t = NT - 1 - it, buf = it & 1;
        u32x4 kreg, vreg;
        if (it + 1 < NT) { const size_t go = (size_t)(64 * (t - 1)) * NPROJ; kreg = *(const u32x4*)(Kb + go); vreg = *(const u32x4*)(Vb + go); }
        if (64 * t <= qw0 && !done) {
            f32x16 p0, p1, m0, m1;
            qk_tile(p0, p1, lds + OFF_K + buf * KBUF, qr, r32, hi);
            const int di = qpos - 64 * t - 4 * hi;
#pragma unroll
            for (int r = 0; r < 16; ++r) {
                const float z0 = p0[r] * 0.125f, z1 = p1[r] * 0.125f;
                const float e0 = __builtin_amdgcn_exp2f(-fabsf(z0) * LOG2E), e1 = __builtin_amdgcn_exp2f(-fabsf(z1) * LOG2E);
                const float ls0 = fminf(z0, 0.f) - __builtin_amdgcn_logf(1.f + e0) * LN2, ls1 = fminf(z1, 0.f) - __builtin_amdgcn_logf(1.f + e1) * LN2;
                const bool v0 = CROW(r) < di, v1 = CROW(r) + 32 < di;
                p0[r] = v0 ? ls0 : -INFINITY; p1[r] = v1 ? ls1 : -INFINITY;
                m0[r] = v0 ? ls0 - z0 : 0.f; m1[r] = v1 ? ls1 - z1 : 0.f; }
            float b0[4], b1[4], c0[4], c1[4];
#pragma unroll
            for (int gq = 0; gq < 4; ++gq) { const float s0 = (m0[4 * gq] + m0[4 * gq + 1]) + (m0[4 * gq + 2] + m0[4 * gq + 3]), s1 = (m1[4 * gq] + m1[4 * gq + 1]) + (m1[4 * gq + 2] + m1[4 * gq + 3]);
                b0[gq] = xhalf(s0); b1[gq] = xhalf(s1); c0[gq] = s0 + b0[gq]; c1[gq] = s1 + b1[gq]; }
            const float tot1 = (c1[0] + c1[1]) + (c1[2] + c1[3]), tot0 = (c0[0] + c0[1]) + (c0[2] + c0[3]);
            float S0[4], S1[4];
            S1[3] = R; S1[2] = S1[3] + c1[3]; S1[1] = S1[2] + c1[2]; S1[0] = S1[1] + c1[1];
            S0[3] = R + tot1; S0[2] = S0[3] + c0[3]; S0[1] = S0[2] + c0[2]; S0[0] = S0[1] + c0[1];
#pragma unroll
            for (int gq = 0; gq < 4; ++gq) {
                float l0 = S0[gq] + (hi == 0 ? b0[gq] : 0.f), l1 = S1[gq] + (hi == 0 ? b1[gq] : 0.f);
#pragma unroll
                for (int e = 3; e >= 0; --e) { const int r = 4 * gq + e;
                    const float w0 = __builtin_amdgcn_exp2f((p0[r] + l0) * LOG2E), w1 = __builtin_amdgcn_exp2f((p1[r] + l1) * LOG2E);
                    l0 += m0[r]; l1 += m1[r]; p0[r] = w0; p1[r] = w1; } }
            R += tot0 + tot1;
            pv_tile<2, VSTRS>(o, lds + OFF_V + buf * VBUFS + vlane, p0, p1);
            done = __all(R < -110.f);
        }
        if (done && lane == 0) (void)__hip_atomic_fetch_add(cnt + it, 1, __ATOMIC_RELAXED, __HIP_MEMORY_SCOPE_WORKGROUP);
        if (it + 1 < NT) { const int nb_ = buf ^ 1; *(LAS u32x4*)(lds + OFF_K + nb_ * KBUF + krow * KSTR + kch * 16) = kreg; *(LAS u32x4*)(lds + OFF_V + nb_ * VBUFS + krow * VSTRS + kch * 16) = vreg; }
        __syncthreads();
        if (__hip_atomic_load(cnt + it, __ATOMIC_RELAXED, __HIP_MEMORY_SCOPE_WORKGROUP) == 8) break;
    }
    float ssq = 0.f;
#pragma unroll
    for (int nb = 0; nb < 2; ++nb)
#pragma unroll
        for (int r = 0; r < 16; ++r) ssq += o[nb][r] * o[nb][r];
    ssq += xhalf(ssq);
    const float inv = rsqrtf(ssq * (1.f / 64.f) + EPS);
    bf16* orow = mixo + (rowb + qpos) * D + 512 + h * 64 + 4 * hi;
#pragma unroll
    for (int nb = 0; nb < 2; ++nb)
#pragma unroll
        for (int gq = 0; gq < 4; ++gq) { const int d = 32 * nb + 8 * gq; const f32x4 gv = *(const f32x4*)(g + d + 4 * hi);
            u32x2 w; w.x = cvtpk(o[nb][4 * gq] * inv * gv[0], o[nb][4 * gq + 1] * inv * gv[1]); w.y = cvtpk(o[nb][4 * gq + 2] * inv * gv[2], o[nb][4 * gq + 3] * inv * gv[3]);
            *(u32x2*)(orow + d) = w; }
}
#undef CROW
}
__global__ void __launch_bounds__(NWAVES * 64, 2) fwd(Args args) {
    extern __shared__ __attribute__((aligned(16))) unsigned char lds[];
    Frame F;
    F.lds = (LAS unsigned char*)lds;
    F.tid = threadIdx.x; F.lane = F.tid & 63; F.wave = __builtin_amdgcn_readfirstlane(F.tid >> 6);
    F.G = gridDim.x; { const int bx = blockIdx.x; F.vcu = (F.G % 8 == 0) ? (bx % 8) * (F.G / 8) + bx / 8 : bx; }
    unsigned char* ws = args.ws;
    const int lo = args.ph_lo, hi = args.ph_hi;
#define IN(k) (lo <= (k) && (k) < hi)
#define SEAM(k) do { if (IN(k) && IN((k) + 1)) { cg::this_grid().sync(); } } while (0)
    if (IN(0)) { p0_prologue(F, args); } SEAM(0);
    if (IN(1)) {
        pg8::Gemm g{(const bf16*)(ws + WS_XN), (const bf16*)(ws + WS_WQKV), M, NPROJ, D}; pg8::StaticOrder S; S.init(M, NPROJ, F.G, (int)blockIdx.x);
        pg8::EpiBf16Plain E{(bf16*)(ws + WS_PROJ), NPROJ};
        pg8::gemm_phase<pg8::EpiBf16Plain, pg8::StaticOrder, PG8_ALIGN, PG8_SP2>(F.lds + RING_OFF, g, S, E);
    } SEAM(1);
    if (IN(2)) {
        const float lam = lam_of(args.in[3], args.in[4], args.in[5], args.in[6]);
        const bf16* proj = (const bf16*)(ws + WS_PROJ); bf16* mixo = (bf16*)(ws + WS_MIX);
        for (int pr = F.vcu; pr < BATCH * 4 * 4; pr += F.G) { const int bh = pr >> 2, s = pr & 3;
            for (int k = 0; k < 2; ++k) mixer::diff_unit(F.lds, proj, mixo, bh >> 2, bh & 3, k ? s : 7 - s, lam, args.in[7]); }
        for (int u = F.vcu; u < BATCH * 8 * 8; u += F.G) { const int bh = u >> 3, qb = (u + (u >> 8) * 3) & 7;
            mixer::sb_unit(F.lds, proj, mixo, bh >> 3, bh & 7, qb, args.in[8]); }
    }
    SEAM(2);
    if (IN(3)) {
        pg8::Gemm g{(const bf16*)(ws + WS_MIX), (const bf16*)(ws + WS_WO), M, D, D}; pg8::StaticOrder S; S.init(M, D, F.G, (int)blockIdx.x);
        pg8::EpiResid E{args.in[0], args.out, (bf16*)(ws + WS_XN), (float*)(ws + WS_SS1), D};
        pg8::gemm_phase<pg8::EpiResid, pg8::StaticOrder, PG8_ALIGN, PG8_SP2>(F.lds + RING_OFF, g, S, E);
    } SEAM(3);
    if (IN(4)) {
        pg8::Gemm g{(const bf16*)(ws + WS_XN), (const bf16*)(ws + WS_W1), M, FF, D}; pg8::StaticOrder S; S.init(M, FF, F.G, (int)blockIdx.x);
        pg8::EpiSqRelu E{(bf16*)(ws + WS_U), FF, (const float*)(ws + WS_SS1)};
        pg8::gemm_phase<pg8::EpiSqRelu, pg8::StaticOrder, PG8_ALIGN, PG8_SP2>(F.lds + RING_OFF, g, S, E);
    } SEAM(4);
    if (IN(5)) {
        pg8::Gemm g{(const bf16*)(ws + WS_U), (const bf16*)(ws + WS_W2), M, D, FF}; pg8::StaticOrder S; S.init(M, D, F.G, (int)blockIdx.x);
        pg8::EpiResid E{args.out, args.out, nullptr, (float*)(ws + WS_SS2), D};
        pg8::gemm_phase<pg8::EpiResid, pg8::StaticOrder, PG8_ALIGN, PG8_SP2>(F.lds + RING_OFF, g, S, E);
    } SEAM(5);
    if (IN(6)) { p6_final(F, args); }
#undef IN
#undef SEAM
}

extern "C" void kernel_launch(void* const* d_in, const int* in_sizes, int n_in, void* d_out, int out_size, void* d_ws, size_t ws_size, hipStream_t stream) {
    static int grid = 0;
    if (grid == 0) {
        if (n_in != 14 || in_sizes[0] != M * D || out_size != M * D || ws_size < WS_END) { fprintf(stderr, "kernel_launch: unexpected shapes (n_in %d, in0 %d, out %d, ws %zu)\n", n_in, n_in > 0 ? in_sizes[0] : -1, out_size, ws_size); grid = -1; return; }
        int dev = 0, cus = 0;
        if (hipGetDevice(&dev) != hipSuccess || hipDeviceGetAttribute(&cus, hipDeviceAttributeMultiprocessorCount, dev) != hipSuccess) { grid = -1; return; }
        if (hipFuncSetAttribute((const void*)fwd, hipFuncAttributeMaxDynamicSharedMemorySize, LDS_BYTES) != hipSuccess) { fprintf(stderr, "kernel_launch: hipFuncSetAttribute failed\n"); grid = -1; return; }
        grid = cus;
    }
    if (grid < 0) return;
    (void)hipMemsetAsync((char*)d_ws + WS_CTL, 0, CTL_ZERO_BYTES, stream);
    Args a{};
    for (int i = 0; i < 14; ++i) a.in[i] = (const float*)d_in[i];
    a.out = (float*)d_out; a.ws = (unsigned char*)d_ws; a.coop = 0; a.pad = 0;
    unsigned char* ws = (unsigned char*)d_ws;
    a.ph_lo = 0; a.ph_hi = 7; a.coop = 1;
    void* kargs[] = {&a};
    hipError_t e = hipLaunchCooperativeKernel((const void*)fwd, dim3(grid), dim3(NWAVES * 64), kargs, LDS_BYTES, stream);
    if (e != hipSuccess) fprintf(stderr, "kernel_launch: cooperative launch failed: %s (grid %d)\n", hipGetErrorString(e), grid);
}
```

```cpp
#include <hip/hip_runtime.h>
#include <hip/hip_cooperative_groups.h>
#include <cstdio>
#include <cstdint>
namespace cg = cooperative_groups;
namespace pg8 {
#define PG8_LAS __attribute__((address_space(3)))
typedef unsigned short bf16_t;
typedef short bf16x8 __attribute__((ext_vector_type(8)));
typedef float f32x4 __attribute__((ext_vector_type(4)));
typedef unsigned u32x4 __attribute__((ext_vector_type(4)));
constexpr int BM = 256, BK = 64, HALF = 128, HTB = HALF * BK * 2  , STAGE_BYTES = 8 * HTB, NXCD = 8, WGM = 8;

__host__ __device__ __forceinline__ int lds_byte(int r, int c) { const int st = (r >> 4) * 2 + (c >> 5), rr = r & 15, cc = c & 31, ob = rr * 64 + cc * 2; return st * 1024 + (ob ^ (((ob >> 9) & 1) << 5)); }
__host__ __device__ __forceinline__ void stage_rc(int b, int& R, int& C) { const int st = b / 1024, sb = b % 1024, swz = sb ^ (((sb >> 9) & 1) << 5); R = (st >> 1) * 16 + swz / 64; C = (st & 1) * 32 + (swz % 64) / 2; }
__host__ __device__ __forceinline__ int perm32(int rho) { const int n = rho >> 4, i = rho & 15; return 8 * (i >> 2) + 4 * n + (i & 3); }

struct Unit { int pm, pn; };
struct Gemm { const bf16_t* A; const bf16_t* Bt; int M, N, K; };

struct StaticOrder {
    int nM, nN, nwg, G, c;
    __host__ __device__ void init(int M, int N, int G_, int c_) { nM = M / BM; nN = N / BM; nwg = nM * nN; G = G_; c = c_; }
    __host__ __device__ bool next(int i, Unit& u) const {
        const long L = (long)i * G + c; if (L >= nwg) return false;
        int wgid = (int)L; { const int q = nwg / NXCD, r = nwg % NXCD, xcd = wgid % NXCD, off = wgid / NXCD; wgid = (xcd < r ? xcd * (q + 1) : r * (q + 1) + (xcd - r) * q) + off; }
        const int nig = WGM * nN, gid = wgid / nig, fm = gid * WGM, gsz = (nM - fm) < WGM ? (nM - fm) : WGM;
        u.pm = fm + ((wgid % nig) % gsz); u.pn = (wgid % nig) / gsz; return true;
    }
    __device__ __forceinline__ void a_ready(const Unit&) const {}
    __device__ __forceinline__ void done(const Unit&) const {}
};

__device__ __forceinline__ unsigned cvt_pk_bf16(float lo, float hi) { unsigned r; asm volatile("v_cvt_pk_bf16_f32 %0, %1, %2" : "=v"(r) : "v"(lo), "v"(hi)); return r; }
typedef unsigned u32x2 __attribute__((ext_vector_type(2)));
struct EpiBf16Plain {
    static constexpr bool PERM = true, AFTER_DRAIN = false;
    bf16_t* O; int ldc;
    __device__ __forceinline__ void operator()(const f32x4 (&acc)[2][2][4][2], const Unit& u, int wr, int wc, int fr, int fq) const {
        const int row0 = u.pm * BM + wr * 64 + fr; const int col0 = u.pn * BM + wc * 32 + 8 * fq;
#pragma unroll
        for (int ai = 0; ai < 2; ++ai)
#pragma unroll
            for (int m = 0; m < 4; ++m) { bf16_t* rowp = O + (size_t)(row0 + ai * HALF + m * 16) * ldc + col0;
#pragma unroll
                for (int bj = 0; bj < 2; ++bj) { const f32x4 v0 = acc[ai][bj][m][0], v1 = acc[ai][bj][m][1];
                    u32x4 w; w.x = cvt_pk_bf16(v0[0], v0[1]); w.y = cvt_pk_bf16(v0[2], v0[3]); w.z = cvt_pk_bf16(v1[0], v1[1]); w.w = cvt_pk_bf16(v1[2], v1[3]);
                    *(u32x4*)(rowp + bj * HALF) = w; } }
    }
};
struct EpiSqRelu {
    static constexpr bool PERM = true, AFTER_DRAIN = false;
    bf16_t* O; int ldc; const float* ss;
    __device__ __forceinline__ void operator()(const f32x4 (&acc)[2][2][4][2], const Unit& u, int wr, int wc, int fr, int fq) const {
        const int row0 = u.pm * BM + wr * 64 + fr; const int col0 = u.pn * BM + wc * 32 + 8 * fq;
#pragma unroll
        for (int ai = 0; ai < 2; ++ai)
#pragma unroll
            for (int m = 0; m < 4; ++m) { const int row = row0 + ai * HALF + m * 16; bf16_t* rowp = O + (size_t)row * ldc + col0;
                const float sv = __hip_atomic_load(ss + row, __ATOMIC_RELAXED, __HIP_MEMORY_SCOPE_AGENT);
                const float inv = rsqrtf(sv * (1.0f / 1024.0f) + 1e-6f), inv2 = inv * inv;
#pragma unroll
                for (int bj = 0; bj < 2; ++bj) { f32x4 v0 = acc[ai][bj][m][0], v1 = acc[ai][bj][m][1];
#pragma unroll
                    for (int e = 0; e < 4; ++e) { const float a = fmaxf(v0[e], 0.f), b = fmaxf(v1[e], 0.f); v0[e] = a * a * inv2; v1[e] = b * b * inv2; }
                    u32x4 w; w.x = cvt_pk_bf16(v0[0], v0[1]); w.y = cvt_pk_bf16(v0[2], v0[3]); w.z = cvt_pk_bf16(v1[0], v1[1]); w.w = cvt_pk_bf16(v1[2], v1[3]);
                    *(u32x4*)(rowp + bj * HALF) = w; } }
    }
};
struct EpiResid {
    static constexpr bool PERM = false, AFTER_DRAIN = false;
    const float* base; float* out; bf16_t* ob; float* ss; int ldc;
    __device__ __forceinline__ void operator()(const f32x4 (&acc)[2][2][4][2], const Unit& u, int wr, int wc, int fr, int fq) const {
        const int col0 = u.pn * BM + wc * 32 + 4 * fq;
#pragma unroll
        for (int ai = 0; ai < 2; ++ai)
#pragma unroll
            for (int m = 0; m < 4; ++m) { const int r = u.pm * BM + ai * HALF + wr * 64 + m * 16 + fr; const size_t off = (size_t)r * ldc + col0; float s = 0.f;
#pragma unroll
                for (int bj = 0; bj < 2; ++bj)
#pragma unroll
                    for (int n = 0; n < 2; ++n) { const f32x4 bs = *(const f32x4*)(base + off + bj * HALF + n * 16); const f32x4 o = bs + acc[ai][bj][m][n];
                        *(f32x4*)(out + off + bj * HALF + n * 16) = o; s += (o[0] * o[0] + o[1] * o[1]) + (o[2] * o[2] + o[3] * o[3]);
                        if (ob) { u32x2 w; w.x = cvt_pk_bf16(o[0], o[1]); w.y = cvt_pk_bf16(o[2], o[3]); *(u32x2*)(ob + off + bj * HALF + n * 16) = w; } }
                s += __shfl_xor(s, 16); s += __shfl_xor(s, 32);
                if (fq == 0) (void)__hip_atomic_fetch_add(ss + r, s, __ATOMIC_RELAXED, __HIP_MEMORY_SCOPE_AGENT); }
    }
};

template <class Epi, class Sched, bool ALIGN_EPI = false, bool SP2 = false>
__device__ __forceinline__ void gemm_phase(PG8_LAS unsigned char* lds, const Gemm g, const Sched& S, const Epi& E) {
    const int tid = threadIdx.x, wid = __builtin_amdgcn_readfirstlane(tid >> 6), lane = tid & 63, wr = wid >> 2, wc = wid & 3, fr = lane & 15, fq = lane >> 4;
    const int K = g.K, nt = K / BK;
    unsigned voffA[2], voffB[2];
#pragma unroll
    for (int i = 0; i < 2; ++i) { int R, C; stage_rc(tid * 16 + i * 8192, R, C); const int Rb = Epi::PERM ? ((R & ~31) + perm32(R & 31)) : R;
        voffA[i] = (unsigned)(R * K + C) * 2u; voffB[i] = (unsigned)(Rb * K + C) * 2u; }
    const size_t kstep = (size_t)(BK * 2);
    const size_t hstep = (size_t)HALF * K * 2;
    const size_t tstep = 2 * hstep;
    const unsigned ldsw = (unsigned)wid * 1024u;
    const int aoff = lds_byte(wr * 64 + fr, fq * 8), boff = lds_byte(wc * 32 + fr, fq * 8);
#define PG8_SA(b, h) (((b) * 2 + (h)) * HTB)
#define PG8_SB(b, h) ((4 + (b) * 2 + (h)) * HTB)
#define PG8_STAGE(bufoff, gbase, voff) do { _Pragma("unroll") for (int _i = 0; _i < 2; ++_i) \
        __builtin_amdgcn_global_load_lds((const unsigned*)((const char*)(gbase) + (voff)[_i]), (PG8_LAS unsigned*)(lds + (bufoff) + ldsw + _i * 8192), 16, 0, 0); } while (0)
#define PG8_LDA(dst, b, h) do { _Pragma("unroll") for (int m = 0; m < 4; ++m) _Pragma("unroll") for (int k = 0; k < 2; ++k) dst[m][k] = *(const PG8_LAS bf16x8*)(lds + PG8_SA(b, h) + aoff + m * 2048 + k * 1024); } while (0)
#define PG8_LDB(dst, b, h) do { _Pragma("unroll") for (int n = 0; n < 2; ++n) _Pragma("unroll") for (int k = 0; k < 2; ++k) dst[n][k] = *(const PG8_LAS bf16x8*)(lds + PG8_SB(b, h) + boff + n * 2048 + k * 1024); } while (0)
#define PG8_MMA(ai, bj, At, Bt) do { __builtin_amdgcn_s_setprio(1); _Pragma("unroll") for (int m = 0; m < 4; ++m) _Pragma("unroll") for (int n = 0; n < 2; ++n) _Pragma("unroll") for (int k = 0; k < 2; ++k) \
        acc[ai][bj][m][n] = __builtin_amdgcn_mfma_f32_16x16x32_bf16(Bt[n][k], At[m][k], acc[ai][bj][m][n], 0, 0, 0); __builtin_amdgcn_s_setprio(0); } while (0)
#define PG8_WAIT_V(n) asm volatile("s_waitcnt vmcnt(" #n ")" ::: "memory")
#define PG8_WAIT_L(n) asm volatile("s_waitcnt lgkmcnt(" #n ")" ::: "memory")
#define PG8_BAR __builtin_amdgcn_s_barrier()
#define PG8_SCHED __builtin_amdgcn_sched_barrier(0)
    Unit cur, nxt; int ui = 0;
    if (!S.next(0, cur)) return;
    f32x4 acc[2][2][4][2];
#pragma unroll
    for (int a = 0; a < 2; ++a)
#pragma unroll
        for (int b = 0; b < 2; ++b)
#pragma unroll
            for (int m = 0; m < 4; ++m)
#pragma unroll
                for (int n = 0; n < 2; ++n) acc[a][b][m][n] = (f32x4){0.f, 0.f, 0.f, 0.f};
    bf16x8 At[4][2], B0[2][2], B1[2][2];
    const char* cA = (const char*)g.A + (size_t)cur.pm * tstep; const char* cB = (const char*)g.Bt + (size_t)cur.pn * tstep;
    S.a_ready(cur);
    if constexpr (SP2) {
        PG8_STAGE(PG8_SB(0, 0), cB, voffB); PG8_STAGE(PG8_SB(0, 1), cB + hstep, voffB); PG8_STAGE(PG8_SA(0, 0), cA, voffA); PG8_STAGE(PG8_SA(0, 1), cA + hstep, voffA);
        if (wr == 1) PG8_BAR;
        PG8_WAIT_V(2); PG8_BAR;
        PG8_STAGE(PG8_SB(1, 0), cB + kstep, voffB); PG8_STAGE(PG8_SA(1, 0), cA + kstep, voffA); PG8_STAGE(PG8_SB(1, 1), cB + hstep + kstep, voffB);
        PG8_WAIT_V(6); PG8_BAR;
    } else {
        PG8_STAGE(PG8_SB(0, 0), cB, voffB); PG8_STAGE(PG8_SA(0, 0), cA, voffA); PG8_STAGE(PG8_SB(0, 1), cB + hstep, voffB); PG8_STAGE(PG8_SA(0, 1), cA + hstep, voffA);
        if (wr == 1) PG8_BAR;
        PG8_WAIT_V(4); PG8_BAR;
        PG8_STAGE(PG8_SB(1, 0), cB + kstep, voffB); PG8_STAGE(PG8_SA(1, 0), cA + kstep, voffA); PG8_STAGE(PG8_SB(1, 1), cB + hstep + kstep, voffB);
        PG8_WAIT_V(6); PG8_BAR;
    }
    for (;;) {
        const bool has_next = S.next(ui + 1, nxt);
        const char* nA = has_next ? (const char*)g.A + (size_t)nxt.pm * tstep : cA; const char* nB = has_next ? (const char*)g.Bt + (size_t)nxt.pn * tstep : cB;
        for (int t = 0; t < nt; t += 2) {
            const bool last = (t == nt - 2);
            const char* a1 = cA + (size_t)(t + 1) * kstep;
            const char* a2 = last ? nA : cA + (size_t)(t + 2) * kstep; const char* b2 = last ? nB : cB + (size_t)(t + 2) * kstep;
            const char* a3 = a2 + kstep; const char* b3 = b2 + kstep;
            if (last && has_next) S.a_ready(nxt);
            if constexpr (SP2) {
            PG8_LDB(B0, 0, 0); PG8_LDB(B1, 0, 1); PG8_SCHED; PG8_LDA(At, 0, 0); PG8_STAGE(PG8_SA(1, 1), a1 + hstep, voffA);
            PG8_WAIT_V(8); PG8_WAIT_L(0); PG8_BAR; PG8_MMA(0, 0, At, B0); PG8_MMA(0, 1, At, B1); PG8_BAR; PG8_SCHED;
            PG8_LDA(At, 0, 1); PG8_STAGE(PG8_SB(0, 0), b2, voffB); PG8_STAGE(PG8_SB(0, 1), b2 + hstep, voffB); PG8_STAGE(PG8_SA(0, 0), a2, voffA);
            PG8_WAIT_V(8); PG8_WAIT_L(0); PG8_BAR; PG8_MMA(1, 0, At, B0); PG8_MMA(1, 1, At, B1); PG8_BAR; PG8_SCHED;
            PG8_LDB(B0, 1, 0); PG8_LDB(B1, 1, 1); PG8_SCHED; PG8_LDA(At, 1, 0); PG8_STAGE(PG8_SA(0, 1), a2 + hstep, voffA);
            PG8_WAIT_V(8); PG8_WAIT_L(0); PG8_BAR; PG8_MMA(0, 0, At, B0); PG8_MMA(0, 1, At, B1); PG8_BAR; PG8_SCHED;
            PG8_LDA(At, 1, 1); PG8_STAGE(PG8_SB(1, 0), b3, voffB); PG8_STAGE(PG8_SB(1, 1), b3 + hstep, voffB); PG8_STAGE(PG8_SA(1, 0), a3, voffA);
            PG8_WAIT_V(8); PG8_WAIT_L(0); PG8_BAR; PG8_MMA(1, 0, At, B0); PG8_MMA(1, 1, At, B1); PG8_BAR; PG8_SCHED;
            } else {
            PG8_LDB(B0, 0, 0); PG8_SCHED; PG8_LDA(At, 0, 0); PG8_STAGE(PG8_SA(1, 1), a1 + hstep, voffA);
            PG8_WAIT_L(8); PG8_BAR; PG8_WAIT_L(0); PG8_MMA(0, 0, At, B0); PG8_BAR; PG8_SCHED;
            PG8_LDB(B1, 0, 1); PG8_STAGE(PG8_SB(0, 0), b2, voffB);
            PG8_BAR; PG8_WAIT_L(0); PG8_MMA(0, 1, At, B1); PG8_BAR;
            PG8_LDA(At, 0, 1); PG8_STAGE(PG8_SA(0, 0), a2, voffA);
            PG8_BAR; PG8_WAIT_L(0); PG8_MMA(1, 0, At, B0); PG8_BAR; PG8_SCHED;
            PG8_STAGE(PG8_SB(0, 1), b2 + hstep, voffB);
            PG8_WAIT_V(6); PG8_BAR; PG8_MMA(1, 1, At, B1); PG8_BAR;
            PG8_LDB(B0, 1, 0); PG8_SCHED; PG8_LDA(At, 1, 0); PG8_STAGE(PG8_SA(0, 1), a2 + hstep, voffA);
            PG8_WAIT_L(8); PG8_BAR; PG8_WAIT_L(0); PG8_MMA(0, 0, At, B0); PG8_BAR; PG8_SCHED;
            PG8_LDB(B1, 1, 1); PG8_STAGE(PG8_SB(1, 0), b3, voffB);
            PG8_BAR; PG8_WAIT_L(0); PG8_MMA(0, 1, At, B1); PG8_BAR;
            PG8_LDA(At, 1, 1); PG8_STAGE(PG8_SA(1, 0), a3, voffA);
            PG8_BAR; PG8_WAIT_L(0); PG8_MMA(1, 0, At, B0); PG8_BAR; PG8_SCHED;
            PG8_STAGE(PG8_SB(1, 1), b3 + hstep, voffB);
            PG8_WAIT_V(6); PG8_BAR; PG8_MMA(1, 1, At, B1); PG8_BAR;
            }
        }
        if constexpr (ALIGN_EPI) { if (wr == 0) PG8_BAR; }
        if constexpr (!Epi::AFTER_DRAIN) { E(acc, cur, wr, wc, fr, fq); S.done(cur); }
        if (!has_next) break;
#pragma unroll
        for (int a = 0; a < 2; ++a)
#pragma unroll
            for (int b = 0; b < 2; ++b)
#pragma unroll
                for (int m = 0; m < 4; ++m)
#pragma unroll
                    for (int n = 0; n < 2; ++n) acc[a][b][m][n] = (f32x4){0.f, 0.f, 0.f, 0.f};
        cur = nxt; cA = nA; cB = nB; ++ui;
        if constexpr (ALIGN_EPI) { if (wr == 1) PG8_BAR; }
    }
    PG8_WAIT_V(0);
    if constexpr (!ALIGN_EPI) { if (wr == 0) PG8_BAR; }
    PG8_BAR;
    if constexpr (Epi::AFTER_DRAIN) { E.fused(acc, cur, wr, wc, fr, fq, lds, wid, lane); S.done(cur); }
#undef PG8_SA
#undef PG8_SB
#undef PG8_STAGE
#undef PG8_LDA
#undef PG8_LDB
#undef PG8_MMA
#undef PG8_WAIT_V
#undef PG8_WAIT_L
#undef PG8_BAR
#undef PG8_SCHED
}
}
#ifndef PG8_SP2
#define PG8_SP2 true
#endif
#ifndef PG8_ALIGN
#define PG8_ALIGN true
#endif
constexpr int NWAVES = 8;
constexpr int BATCH = 16, SEQ = 2048, D = 1024, FF = 4096, NPROJ = 3072;
constexpr int M = BATCH * SEQ;
constexpr float EPS = 1e-6f;
constexpr int C_DQ = 0, C_DK = 512, C_DV = 1024, C_SQ = 1536, C_SK = 2048, C_SV = 2560;
constexpr size_t MiB = 1u << 20;
constexpr size_t WS_CTL = 0, CTL_ZERO_BYTES = 1 * MiB;
constexpr size_t WS_SS1 = 0, WS_SS2 = 256 * 1024;
constexpr size_t WS_WQKV = 2 * MiB, WS_WO = 8 * MiB, WS_W1 = 10 * MiB, WS_W2 = 18 * MiB;
constexpr size_t WS_XN = 32 * MiB;
constexpr size_t WS_PROJ = 96 * MiB;
constexpr size_t WS_MIX = 288 * MiB;
constexpr size_t WS_U = 96 * MiB;
constexpr size_t WS_END = 352 * MiB;
constexpr int RING_OFF = 0, RING_BYTES = 131072;
constexpr int LDS_BYTES = 147456;

#define GAS __attribute__((address_space(1)))
#define LAS __attribute__((address_space(3)))
typedef unsigned short bf16;
typedef unsigned v4u __attribute__((ext_vector_type(4)));
typedef float f32x4 __attribute__((ext_vector_type(4)));
#define LDS_WAIT() asm volatile("s_waitcnt lgkmcnt(0)" ::: "memory")
__device__ __forceinline__ unsigned f2bf(float f) { unsigned u = __builtin_bit_cast(unsigned, f); return (u + 0x7fffu + ((u >> 16) & 1u)) >> 16; }
__device__ __forceinline__ unsigned pk2(float lo, float hi) { return f2bf(lo) | (f2bf(hi) << 16); }
__device__ __forceinline__ float bflo(unsigned w) { return __builtin_bit_cast(float, w << 16); }
__device__ __forceinline__ float bfhi(unsigned w) { return __builtin_bit_cast(float, w & 0xffff0000u); }

struct Frame {
    LAS unsigned char* lds;
    int tid, lane, wave, vcu, G;
};
__device__ __forceinline__ float wave_sum(float v) {
#pragma unroll
    for (int o = 1; o < 64; o <<= 1) v += __shfl_xor(v, o);
    return v;
}
__device__ __forceinline__ void p0_transpose_item(const float* W, int K, int N, bf16* WT, const float* ks, LAS float* scr, int item, int lane) {
    const int nblk = N / 32, kb = item / nblk, nb = item % nblk, k0 = 64 * kb, n0 = 32 * nb;
#pragma unroll 8
    for (int i = 0; i < 32; ++i) { const int kk = 2 * i + (lane >> 5); float v = W[(size_t)(k0 + kk) * N + n0 + (lane & 31)]; if (ks) v *= ks[k0 + kk]; scr[kk * 33 + (lane & 31)] = v; }
    LDS_WAIT(); asm volatile("" ::: "memory");
    const int c = lane & 7;
#pragma unroll
    for (int j = 0; j < 4; ++j) { const int n = (lane >> 3) + 8 * j; const LAS float* s = scr + (8 * c) * 33 + n;
        v4u o; o.x = pk2(s[0 * 33], s[1 * 33]); o.y = pk2(s[2 * 33], s[3 * 33]); o.z = pk2(s[4 * 33], s[5 * 33]); o.w = pk2(s[6 * 33], s[7 * 33]);
        *(GAS v4u*)(WT + (size_t)(n0 + n) * K + k0 + 8 * c) = o; }
    LDS_WAIT(); asm volatile("" ::: "memory");
}
__device__ __forceinline__ void rms_row_to_bf16(int lane, const float* xrow, const float* g, bf16* orow) {
    const GAS f32x4* xr = (const GAS f32x4*)xrow + lane; const GAS f32x4* gr = (const GAS f32x4*)g + lane;
    f32x4 v[4]; float s = 0.f;
#pragma unroll
    for (int j = 0; j < 4; ++j) { v[j] = xr[64 * j]; s += (v[j].x * v[j].x + v[j].y * v[j].y) + (v[j].z * v[j].z + v[j].w * v[j].w); }
    const float inv = rsqrtf(wave_sum(s) * (1.f / D) + EPS);
    GAS unsigned long long* o8 = (GAS unsigned long long*)orow + lane;
#pragma unroll
    for (int j = 0; j < 4; ++j) { const f32x4 gg = gr[64 * j];
        o8[64 * j] = (unsigned long long)pk2(v[j].x * inv * gg.x, v[j].y * inv * gg.y) | ((unsigned long long)pk2(v[j].z * inv * gg.z, v[j].w * inv * gg.w) << 32); }
}
struct Args { const float* in[14]; float* out; unsigned char* ws; int ph_lo, ph_hi, coop, pad; };

__device__ __forceinline__ void p0_prologue(Frame& F, const Args& a) {
    LAS float* scr = (LAS float*)(F.lds + RING_OFF + F.wave * 16384);
    const int gw = F.vcu * NWAVES + F.wave, NGW = F.G * NWAVES;
    unsigned char* ws = a.ws;
    constexpr int I_IN = (D / 64) * (NPROJ / 32), I_O = (D / 64) * (D / 32), I_1 = (D / 64) * (FF / 32), I_2 = (FF / 64) * (D / 32);
    constexpr int NITEMS = I_IN + I_O + I_1 + I_2;
    for (int it = gw; it < NITEMS; it += NGW) {
        int r = it;
        if (r < I_IN) { p0_transpose_item(a.in[2], D, NPROJ, (bf16*)(ws + WS_WQKV), nullptr, scr, r, F.lane); continue; } r -= I_IN;
        if (r < I_O) { p0_transpose_item(a.in[9], D, D, (bf16*)(ws + WS_WO), nullptr, scr, r, F.lane); continue; } r -= I_O;
        if (r < I_1) { p0_transpose_item(a.in[11], D, FF, (bf16*)(ws + WS_W1), a.in[10], scr, r, F.lane); continue; } r -= I_1;
        p0_transpose_item(a.in[12], FF, D, (bf16*)(ws + WS_W2), nullptr, scr, r, F.lane);
    }
    for (int m = gw; m < M; m += NGW) rms_row_to_bf16(F.lane, a.in[0] + (size_t)m * D, a.in[1], (bf16*)(ws + WS_XN) + (size_t)m * D);
}
__device__ __forceinline__ void p6_final(Frame& F, const Args& a, float* dst) {
    const int gw = F.vcu * NWAVES + F.wave, NGW = F.G * NWAVES;
    const float* ss2 = (const float*)(a.ws + WS_SS2); const GAS f32x4* gr = (const GAS f32x4*)a.in[13] + F.lane;
    f32x4 gg[4];
#pragma unroll
    for (int j = 0; j < 4; ++j) gg[j] = gr[64 * j];
    for (int m = gw; m < M; m += NGW) {
        const float inv = rsqrtf(__hip_atomic_load(ss2 + m, __ATOMIC_RELAXED, __HIP_MEMORY_SCOPE_AGENT) * (1.f / D) + EPS);
        const GAS f32x4* o = (const GAS f32x4*)(a.out + (size_t)m * D) + F.lane; GAS f32x4* w = (GAS f32x4*)(dst + (size_t)m * D) + F.lane;
#pragma unroll
        for (int j = 0; j < 4; ++j) { f32x4 v = o[64 * j]; v = v * inv * gg[j]; w[64 * j] = v; }
    }
}
typedef unsigned u32x4g __attribute__((ext_vector_type(4)));
__device__ __forceinline__ float lam_of(const float* lq1, const float* lk1, const float* lq2, const float* lk2) {
    float s1 = 0.f, s2 = 0.f;
    for (int i = 0; i < 64; ++i) { s1 += lq1[i] * lk1[i]; s2 += lq2[i] * lk2[i]; }
    return __expf(s1) - __expf(s2) + 0.2f;
}
namespace mixer {
typedef short bf16x8 __attribute__((ext_vector_type(8)));
typedef short s16x4 __attribute__((ext_vector_type(4)));
typedef short v4i16_t __attribute__((ext_vector_type(4)));
typedef float f32x16 __attribute__((ext_vector_type(16)));
typedef unsigned u32x4 __attribute__((ext_vector_type(4)));
typedef unsigned u32x2 __attribute__((ext_vector_type(2)));
typedef float f32x2_t __attribute__((ext_vector_type(2))); typedef __bf16 bf16x2_t __attribute__((ext_vector_type(2)));
constexpr int KSTR = 144, KBUF = 64 * KSTR;
constexpr int VSTRD = 320, VBUFD = 64 * VSTRD;
constexpr int VSTRS = 192, VBUFS = 64 * VSTRS;
constexpr int OFF_K = 0, OFF_V = 2 * KBUF, OFF_CNT = OFF_V + 2 * VBUFD, OFF_O1 = OFF_CNT + 128;
static_assert(OFF_O1 + 65536 <= RING_BYTES, "mixer LDS map");
constexpr float LOG2E = 1.4426950408889634f, LN2 = 0.6931471805599453f;
__device__ __forceinline__ s16x4 vtr(const LAS unsigned char* p) { return __builtin_bit_cast(s16x4, __builtin_amdgcn_ds_read_tr16_b64_v4i16((LAS v4i16_t*)p)); }
__device__ __forceinline__ unsigned cvtpk(float lo, float hi) { f32x2_t v = {lo, hi}; bf16x2_t b = __builtin_convertvector(v, bf16x2_t); return __builtin_bit_cast(unsigned, b); }
__device__ __forceinline__ float xhalf(float v) { return __shfl_xor(v, 32); }
#define CROW(r) (((r) & 3) + 8 * ((r) >> 2))
__device__ __forceinline__ void qk_tile(f32x16& p0, f32x16& p1, const LAS unsigned char* Kt, const bf16x8 (&qr)[4], int r32, int hi) {
    const LAS unsigned char* kb = Kt + r32 * KSTR + hi * 16;
#pragma unroll
    for (int r = 0; r < 16; ++r) { p0[r] = 0.f; p1[r] = 0.f; }
#pragma unroll
    for (int d0 = 0; d0 < 4; ++d0) {
        const bf16x8 a0 = *(const LAS bf16x8*)(kb + d0 * 32), a1 = *(const LAS bf16x8*)(kb + 32 * KSTR + d0 * 32);
        p0 = __builtin_amdgcn_mfma_f32_32x32x16_bf16(a0, qr[d0], p0, 0, 0, 0); p1 = __builtin_amdgcn_mfma_f32_32x32x16_bf16(a1, qr[d0], p1, 0, 0, 0); }
}
template <int NB, int VSTR> __device__ __forceinline__ void pv_tile(f32x16 (&o)[NB], const LAS unsigned char* vb, const f32x16& p0, const f32x16& p1) {
    u32x4 pw[4];
#pragma unroll
    for (int e = 0; e < 4; ++e) { pw[0][e] = cvtpk(p0[2 * e], p0[2 * e + 1]); pw[1][e] = cvtpk(p0[8 + 2 * e], p0[9 + 2 * e]); pw[2][e] = cvtpk(p1[2 * e], p1[2 * e + 1]); pw[3][e] = cvtpk(p1[8 + 2 * e], p1[9 + 2 * e]); }
#pragma unroll
    for (int ks = 0; ks < 4; ++ks)
#pragma unroll
        for (int nb = 0; nb < NB; ++nb) {
            const s16x4 lo = vtr(vb + (ks * 16) * VSTR + nb * 64), hh = vtr(vb + (ks * 16 + 8) * VSTR + nb * 64);
            const bf16x8 vf = {lo[0], lo[1], lo[2], lo[3], hh[0], hh[1], hh[2], hh[3]};
            o[nb] = __builtin_amdgcn_mfma_f32_32x32x16_bf16(vf, __builtin_bit_cast(bf16x8, pw[ks]), o[nb], 0, 0, 0); }
}
__device__ __forceinline__ void diff_unit(LAS unsigned char* lds, const bf16* proj, bf16* mixo, int b, int h, int qb, float lam, const float* g) {
    const int tid = threadIdx.x, lane = tid & 63, r32 = lane & 31, hi = lane >> 5, wid = __builtin_amdgcn_readfirstlane(tid >> 6);
    const size_t rowb = (size_t)b * SEQ; const int q0 = qb * 256, qw0 = q0 + wid * 32, qpos = qw0 + r32, NT = (q0 + 256) / 64;
    const float slope2 = exp2f(-2.f * (float)(h + 1)) * LOG2E, C2 = 0.125f * LOG2E;
    const int krow = tid >> 3, kch = tid & 7, vrow = tid >> 4, vch = tid & 15;
    const int vlane = (4 * (lane >> 5) + ((lane & 15) >> 2)) * VSTRD + (16 * ((lane >> 4) & 1) + 4 * (lane & 3)) * 2;
    LAS unsigned* o1s = (LAS unsigned*)(lds + OFF_O1) + wid * 2048 + lane;
    f32x16 o[4];
    for (int map = 0; map < 2; ++map) {
        const bf16* Qp = proj + (rowb + qpos) * NPROJ + C_DQ + h * 128 + map * 64;
        const bf16* Kb = proj + rowb * NPROJ + C_DK + h * 128 + map * 64 + (size_t)krow * NPROJ + kch * 8;
        const bf16* Vb = proj + rowb * NPROJ + C_DV + h * 128 + (size_t)vrow * NPROJ + vch * 8;
        bf16x8 qr[4];
#pragma unroll
        for (int d0 = 0; d0 < 4; ++d0) qr[d0] = *(const bf16x8*)(Qp + 16 * d0 + 8 * hi);
#pragma unroll
        for (int nb = 0; nb < 4; ++nb)
#pragma unroll
            for (int r = 0; r < 16; ++r) o[nb][r] = 0.f;
        float mref = -1e30f, l = 0.f;
        u32x4 kreg = *(const u32x4*)(Kb), vreg0 = *(const u32x4*)(Vb), vreg1 = *(const u32x4*)(Vb + (size_t)32 * NPROJ);
        __syncthreads();
        *(LAS u32x4*)(lds + OFF_K + krow * KSTR + kch * 16) = kreg; *(LAS u32x4*)(lds + OFF_V + vrow * VSTRD + vch * 16) = vreg0; *(LAS u32x4*)(lds + OFF_V + (vrow + 32) * VSTRD + vch * 16) = vreg1;
        __syncthreads();
        for (int t = 0; t < NT; ++t) {
            const int buf = t & 1;
            if (t + 1 < NT) { const size_t go = (size_t)(64 * (t + 1)) * NPROJ; kreg = *(const u32x4*)(Kb + go); vreg0 = *(const u32x4*)(Vb + go); vreg1 = *(const u32x4*)(Vb + go + (size_t)32 * NPROJ); }
            if (64 * t <= qw0) {
                f32x16 p0, p1;
                qk_tile(p0, p1, lds + OFF_K + buf * KBUF, qr, r32, hi);
                const int di = qpos - 64 * t - 4 * hi; const float bb = -slope2 * (float)di;
                const bool diag = (64 * t + 63 > qw0);
                float rm = -INFINITY;
#pragma unroll
                for (int r = 0; r < 16; ++r) {
                    p0[r] = __builtin_fmaf(p0[r], C2, __builtin_fmaf(slope2, (float)CROW(r), bb)); p1[r] = __builtin_fmaf(p1[r], C2, __builtin_fmaf(slope2, (float)(CROW(r) + 32), bb));
                    if (diag) { if (CROW(r) > di) p0[r] = -INFINITY; if (CROW(r) + 32 > di) p1[r] = -INFINITY; }
                    rm = fmaxf(rm, fmaxf(p0[r], p1[r])); }
                rm = fmaxf(rm, xhalf(rm));
                if (__any(rm > mref + 8.f)) {
                    const float mn = fmaxf(mref, rm), al = __builtin_amdgcn_exp2f(mref - mn); mref = mn; l *= al;
#pragma unroll
                    for (int nb = 0; nb < 4; ++nb)
#pragma unroll
                        for (int r = 0; r < 16; ++r) o[nb][r] *= al; }
                float ps = 0.f;
#pragma unroll
                for (int r = 0; r < 16; ++r) { p0[r] = __builtin_amdgcn_exp2f(p0[r] - mref); p1[r] = __builtin_amdgcn_exp2f(p1[r] - mref); ps += p0[r] + p1[r]; }
                l += ps;
                pv_tile<4, VSTRD>(o, lds + OFF_V + buf * VBUFD + vlane, p0, p1);
            }
            if (t + 1 < NT) { const int nb_ = buf ^ 1; *(LAS u32x4*)(lds + OFF_K + nb_ * KBUF + krow * KSTR + kch * 16) = kreg;
                *(LAS u32x4*)(lds + OFF_V + nb_ * VBUFD + vrow * VSTRD + vch * 16) = vreg0; *(LAS u32x4*)(lds + OFF_V + nb_ * VBUFD + (vrow + 32) * VSTRD + vch * 16) = vreg1; }
            __syncthreads();
        }
        const float lt = l + xhalf(l);
        if (map == 0) { const float rl = 1.f / lt;
#pragma unroll
            for (int nb = 0; nb < 4; ++nb)
#pragma unroll
                for (int k = 0; k < 8; ++k) o1s[(nb * 8 + k) * 64] = cvtpk(o[nb][2 * k] * rl, o[nb][2 * k + 1] * rl);
        } else { const float rl2 = lam / lt; float ssq = 0.f;
#pragma unroll
            for (int nb = 0; nb < 4; ++nb)
#pragma unroll
                for (int k = 0; k < 8; ++k) { const unsigned ow = o1s[(nb * 8 + k) * 64]; const float a = bflo(ow) - o[nb][2 * k] * rl2, c = bfhi(ow) - o[nb][2 * k + 1] * rl2; o[nb][2 * k] = a; o[nb][2 * k + 1] = c; ssq += a * a + c * c; }
            ssq += xhalf(ssq);
            const float inv = rsqrtf(ssq * (1.f / 128.f) + EPS) * 0.8f;
            bf16* orow = mixo + (rowb + qpos) * D + h * 128 + 4 * hi;
#pragma unroll
            for (int nb = 0; nb < 4; ++nb)
#pragma unroll
                for (int gq = 0; gq < 4; ++gq) { const int d = 32 * nb + 8 * gq; const f32x4 gv = *(const f32x4*)(g + d + 4 * hi);
                    u32x2 w; w.x = cvtpk(o[nb][4 * gq] * inv * gv[0], o[nb][4 * gq + 1] * inv * gv[1]); w.y = cvtpk(o[nb][4 * gq + 2] * inv * gv[2], o[nb][4 * gq + 3] * inv * gv[3]);
                    *(u32x2*)(orow + d) = w; }
        }
    }
}
__device__ __forceinline__ void sb_unit(LAS unsigned char* lds, const bf16* proj, bf16* mixo, int b, int h, int qb, const float* g) {
    const int tid = threadIdx.x, lane = tid & 63, r32 = lane & 31, hi = lane >> 5, wid = __builtin_amdgcn_readfirstlane(tid >> 6);
    const size_t rowb = (size_t)b * SEQ; const int q0 = qb * 256, qw0 = q0 + wid * 32, qpos = qw0 + r32, NT = (q0 + 256) / 64;
    const int krow = tid >> 3, kch = tid & 7;
    const int vlane = (4 * (lane >> 5) + ((lane & 15) >> 2)) * VSTRS + (16 * ((lane >> 4) & 1) + 4 * (lane & 3)) * 2;
    LAS int* cnt = (LAS int*)(lds + OFF_CNT);
    const bf16* Qp = proj + (rowb + qpos) * NPROJ + C_SQ + h * 64;
    const bf16* Kb = proj + rowb * NPROJ + C_SK + h * 64 + (size_t)krow * NPROJ + kch * 8;
    const bf16* Vb = proj + rowb * NPROJ + C_SV + h * 64 + (size_t)krow * NPROJ + kch * 8;
    bf16x8 qr[4];
#pragma unroll
    for (int d0 = 0; d0 < 4; ++d0) qr[d0] = *(const bf16x8*)(Qp + 16 * d0 + 8 * hi);
    f32x16 o[2];
#pragma unroll
    for (int nb = 0; nb < 2; ++nb)
#pragma unroll
        for (int r = 0; r < 16; ++r) o[nb][r] = 0.f;
    float R = 0.f; bool done = false;
    { const size_t go = (size_t)(64 * (NT - 1)) * NPROJ; u32x4 kreg = *(const u32x4*)(Kb + go), vreg = *(const u32x4*)(Vb + go);
      __syncthreads();
      if (tid < 32) cnt[tid] = 0;
      *(LAS u32x4*)(lds + OFF_K + krow * KSTR + kch * 16) = kreg; *(LAS u32x4*)(lds + OFF_V + krow * VSTRS + kch * 16) = vreg;
      __syncthreads(); }
    for (int it = 0; it < NT; ++it) {
        const int t = NT - 1 - it, buf = it & 1;
        u32x4 kreg, vreg;
        if (it + 1 < NT) { const size_t go = (size_t)(64 * (t - 1)) * NPROJ; kreg = *(const u32x4*)(Kb + go); vreg = *(const u32x4*)(Vb + go); }
        if (64 * t <= qw0 && !done) {
            f32x16 p0, p1, m0, m1;
            qk_tile(p0, p1, lds + OFF_K + buf * KBUF, qr, r32, hi);
            const int di = qpos - 64 * t - 4 * hi;
#pragma unroll
            for (int r = 0; r < 16; ++r) {
                const float z0 = p0[r] * 0.125f, z1 = p1[r] * 0.125f;
                const float e0 = __builtin_amdgcn_exp2f(-fabsf(z0) * LOG2E), e1 = __builtin_amdgcn_exp2f(-fabsf(z1) * LOG2E);
                const float ls0 = fminf(z0, 0.f) - __builtin_amdgcn_logf(1.f + e0) * LN2, ls1 = fminf(z1, 0.f) - __builtin_amdgcn_logf(1.f + e1) * LN2;
                const bool v0 = CROW(r) < di, v1 = CROW(r) + 32 < di;
                p0[r] = v0 ? ls0 : -INFINITY; p1[r] = v1 ? ls1 : -INFINITY;
                m0[r] = v0 ? ls0 - z0 : 0.f; m1[r] = v1 ? ls1 - z1 : 0.f; }
            float b0[4], b1[4], c0[4], c1[4];
#pragma unroll
            for (int gq = 0; gq < 4; ++gq) { const float s0 = (m0[4 * gq] + m0[4 * gq + 1]) + (m0[4 * gq + 2] + m0[4 * gq + 3]), s1 = (m1[4 * gq] + m1[4 * gq + 1]) + (m1[4 * gq + 2] + m1[4 * gq + 3]);
                b0[gq] = xhalf(s0); b1[gq] = xhalf(s1); c0[gq] = s0 + b0[gq]; c1[gq] = s1 + b1[gq]; }
            const float tot1 = (c1[0] + c1[1]) + (c1[2] + c1[3]), tot0 = (c0[0] + c0[1]) + (c0[2] + c0[3]);
            float S0[4], S1[4];
            S1[3] = R; S1[2] = S1[3] + c1[3]; S1[1] = S1[2] + c1[2]; S1[0] = S1[1] + c1[1];
            S0[3] = R + tot1; S0[2] = S0[3] + c0[3]; S0[1] = S0[2] + c0[2]; S0[0] = S0[1] + c0[1];
#pragma unroll
            for (int gq = 0; gq < 4; ++gq) {
                float l0 = S0[gq] + (hi == 0 ? b0[gq] : 0.f), l1 = S1[gq] + (hi == 0 ? b1[gq] : 0.f);
#pragma unroll
                for (int e = 3; e >= 0; --e) { const int r = 4 * gq + e;
                    const float w0 = __builtin_amdgcn_exp2f((p0[r] + l0) * LOG2E), w1 = __builtin_amdgcn_exp2f((p1[r] + l1) * LOG2E);
                    l0 += m0[r]; l1 += m1[r]; p0[r] = w0; p1[r] = w1; } }
            R += tot0 + tot1;
            pv_tile<2, VSTRS>(o, lds + OFF_V + buf * VBUFS + vlane, p0, p1);
            done = __all(R < -110.f);
        }
        if (done && lane == 0) (void)__hip_atomic_fetch_add(cnt + it, 1, __ATOMIC_RELAXED, __HIP_MEMORY_SCOPE_WORKGROUP);
        if (it + 1 < NT) { const int nb_ = buf ^ 1; *(LAS u32x4*)(lds + OFF_K + nb_ * KBUF + krow * KSTR + kch * 16) = kreg; *(LAS u32x4*)(lds + OFF_V + nb_ * VBUFS + krow * VSTRS + kch * 16) = vreg; }
        __syncthreads();
        if (__hip_atomic_load(cnt + it, __ATOMIC_RELAXED, __HIP_MEMORY_SCOPE_WORKGROUP) == 8) break;
    }
    float ssq = 0.f;
#pragma unroll
    for (int nb = 0; nb < 2; ++nb)
#pragma unroll
        for (int r = 0; r < 16; ++r) ssq += o[nb][r] * o[nb][r];
    ssq += xhalf(ssq);
    const float inv = rsqrtf(ssq * (1.f / 64.f) + EPS);
    bf16* orow = mixo + (rowb + qpos) * D + 512 + h * 64 + 4 * hi;
#pragma unroll
    for (int nb = 0; nb < 2; ++nb)
#pragma unroll
        for (int gq = 0; gq < 4; ++gq) { const int d = 32 * nb + 8 * gq; const f32x4 gv = *(const f32x4*)(g + d + 4 * hi);
            u32x2 w; w.x = cvtpk(o[nb][4 * gq] * inv * gv[0], o[nb][4 * gq + 1] * inv * gv[1]); w.y = cvtpk(o[nb][4 * gq + 2] * inv * gv[2], o[nb][4 * gq + 3] * inv * gv[3]);
            *(u32x2*)(orow + d) = w; }
}
#undef CROW
}
#ifndef REP0
#define REP0 1
#endif
#ifndef REP1
#define REP1 1
#endif
#ifndef REP2D
#define REP2D 1
#endif
#ifndef REP2S
#define REP2S 1
#endif
#ifndef REP3
#define REP3 1
#endif
#ifndef REP5
#define REP5 1
#endif
#ifndef REP6
#define REP6 1
#endif
#ifndef REP4
#define REP4 1
#endif
typedef GAS unsigned gu32;
constexpr size_t WS_BAR = 768 * 1024;
constexpr int MISC_OFF = RING_BYTES + 320;
#define XB_TMO      128
#define XB_XCNT(j)  (256  + 64 * (j))
#define XB_XSUB(j)  (1280 + 64 * (j))
#define XB_XGEN(j)  (2304 + 64 * (j))
#define XB_TOP      3328
#define XB_TOPGEN   3392
#define XCD_BAR_WORDS 3456
#define XB_SPIN_CAP (1u << 18)

__device__ __forceinline__ unsigned xb_ld(unsigned* p)              { return __hip_atomic_load(p, __ATOMIC_RELAXED, __HIP_MEMORY_SCOPE_AGENT); }
__device__ __forceinline__ unsigned xb_add(unsigned* p, unsigned v) { return __hip_atomic_fetch_add(p, v, __ATOMIC_RELAXED, __HIP_MEMORY_SCOPE_AGENT); }
__device__ __forceinline__ unsigned xb_xcc_id() { return (unsigned)__builtin_amdgcn_s_getreg((3 << 11) | 20) & 0xFu; }
#define XB_SPIN(cond, bar) do { unsigned _sp = 0; while (cond) { __builtin_amdgcn_s_sleep(1); \
    if ((++_sp & 255u) == 0u) { if (xb_ld(&(bar)[XB_TMO])) break; if (_sp > XB_SPIN_CAP) { atomicAdd(&(bar)[XB_TMO], 1u); break; } } } } while (0)

struct XcdBarrier {
    unsigned* bar; unsigned x;
    volatile LAS unsigned* st;
};

__device__ __forceinline__ XcdBarrier xcd_barrier_post(unsigned* bar, volatile LAS unsigned* st) {
    XcdBarrier b; b.bar = bar; b.x = xb_xcc_id(); b.st = st;
    if (threadIdx.x == 0) (void)xb_add(&bar[XB_XCNT(b.x)], 1u);
    return b;
}
__device__ __forceinline__ void xcd_barrier_complete(unsigned* bar, unsigned x, unsigned& nloc, unsigned& nx) {
    const unsigned G = gridDim.x * gridDim.y * gridDim.z;
    unsigned sum, cnt, mine, sp = 0u;
    for (;;) {
        sum = 0u; cnt = 0u; mine = 0u;
#pragma unroll
        for (unsigned j = 0; j < 16; ++j) { const unsigned c = xb_ld(&bar[XB_XCNT(j)]); sum += c; cnt += (c > 0u) ? 1u : 0u; mine = (j == x) ? c : mine; }
        if (sum == G) break;
        __builtin_amdgcn_s_sleep(1);
        if ((++sp & 255u) == 0u) { if (xb_ld(&bar[XB_TMO])) break; if (sp > XB_SPIN_CAP) { atomicAdd(&bar[XB_TMO], 1u); break; } }
    }
    nloc = mine > 0u ? mine : 1u; nx = cnt > 0u ? cnt : 1u;
}

__device__ __forceinline__ void xcd_barrier(const XcdBarrier& b) {
    asm volatile("s_waitcnt vmcnt(0)" ::: "memory");
    __syncthreads();
    if (threadIdx.x == 0) {
        unsigned* bar = b.bar;
        __builtin_amdgcn_s_waitcnt(0);
        unsigned nloc = b.st[0], nx = b.st[1];
        if (nloc == 0u) { xcd_barrier_complete(bar, b.x, nloc, nx); b.st[0] = nloc; b.st[1] = nx; }
        const unsigned old = xb_add(&bar[XB_XSUB(b.x)], 1u);
        const unsigned gen = old / nloc;
        if (old + 1u == (gen + 1u) * nloc) {
            __builtin_amdgcn_fence(__ATOMIC_RELEASE, "agent");
            asm volatile("s_waitcnt vmcnt(0)" ::: "memory");
            const unsigned og = xb_add(&bar[XB_TOP], 1u);
            const unsigned tg = og / nx;
            if (og + 1u == (tg + 1u) * nx) xb_add(&bar[XB_TOPGEN], 1u);
            else XB_SPIN(xb_ld(&bar[XB_TOPGEN]) == tg, bar);
            __builtin_amdgcn_fence(__ATOMIC_ACQUIRE, "agent");
            xb_add(&bar[XB_XGEN(b.x)], 1u);
            asm volatile("s_waitcnt vmcnt(0)" ::: "memory");
        } else {
            XB_SPIN(xb_ld(&bar[XB_XGEN(b.x)]) == gen, bar);
            __builtin_amdgcn_fence(__ATOMIC_ACQUIRE, "agent");
            asm volatile("s_waitcnt vmcnt(0)" ::: "memory");
        }
    }
    __syncthreads();
}

__global__ void __launch_bounds__(NWAVES * 64, 2) fwd(Args args) {
    extern __shared__ __attribute__((aligned(16))) unsigned char lds[];
    Frame F;
    F.lds = (LAS unsigned char*)lds;
    F.tid = threadIdx.x; F.lane = F.tid & 63; F.wave = __builtin_amdgcn_readfirstlane(F.tid >> 6);
    F.G = gridDim.x; { const int bx = blockIdx.x; F.vcu = (F.G % 8 == 0) ? (bx % 8) * (F.G / 8) + bx / 8 : bx; }
    unsigned char* ws = args.ws;
    const int lo = args.ph_lo, hi = args.ph_hi;
    for (int u = F.tid; u < (LDS_BYTES - RING_BYTES) / 4; u += NWAVES * 64) ((LAS unsigned*)(F.lds + RING_BYTES))[u] = 0u;
    __syncthreads();
    if (args.coop == 2) cg::this_grid().sync();
    XcdBarrier bar = xcd_barrier_post((unsigned*)(ws + WS_BAR), (volatile LAS unsigned*)(F.lds + MISC_OFF) + 8);
#define IN(k) (lo <= (k) && (k) < hi)
#define SEAM(k) do { if (IN(k) && IN((k) + 1)) { xcd_barrier(bar); } } while (0)
    if (IN(0)) { for (int rep = 0; rep < REP0; ++rep) p0_prologue(F, args); } SEAM(0);
    if (IN(1)) for (int rep = 0; rep < REP1; ++rep) {
        pg8::Gemm g{(const bf16*)(ws + WS_XN), (const bf16*)(ws + WS_WQKV), M, NPROJ, D}; pg8::StaticOrder S; S.init(M, NPROJ, F.G, (int)blockIdx.x);
        pg8::EpiBf16Plain E{(bf16*)(ws + WS_PROJ), NPROJ};
        pg8::gemm_phase<pg8::EpiBf16Plain, pg8::StaticOrder, PG8_ALIGN, PG8_SP2>(F.lds + RING_OFF, g, S, E);
    } SEAM(1);
    if (IN(2)) {
        const float lam = lam_of(args.in[3], args.in[4], args.in[5], args.in[6]);
        const bf16* proj = (const bf16*)(ws + WS_PROJ); bf16* mixo = (bf16*)(ws + WS_MIX);
        for (int pr_ = F.vcu; pr_ < BATCH * 4 * 4 * REP2D; pr_ += F.G) { const int pr = pr_ & (BATCH * 4 * 4 - 1), bh = pr >> 2, s = pr & 3;
            for (int k = 0; k < 2; ++k) mixer::diff_unit(F.lds, proj, mixo, bh >> 2, bh & 3, k ? s : 7 - s, lam, args.in[7]); }
        for (int u_ = F.vcu; u_ < BATCH * 8 * 8 * REP2S; u_ += F.G) { const int u = u_ & (BATCH * 8 * 8 - 1), bh = u >> 3, qb = (u + (u >> 8) * 3) & 7;
            mixer::sb_unit(F.lds, proj, mixo, bh >> 3, bh & 7, qb, args.in[8]); }
    }
    SEAM(2);
    if (IN(3) && REP3 > 1) {
        pg8::Gemm g{(const bf16*)(ws + WS_MIX), (const bf16*)(ws + WS_WO), M, D, D}; pg8::StaticOrder S; S.init(M, D, F.G, (int)blockIdx.x);
        pg8::EpiResid E{args.in[0], (float*)(ws + WS_PROJ), (bf16*)(ws + WS_PROJ + 128 * MiB), (float*)(ws + 512 * 1024), D};
        pg8::gemm_phase<pg8::EpiResid, pg8::StaticOrder, PG8_ALIGN, PG8_SP2>(F.lds + RING_OFF, g, S, E);
    }
    if (IN(3)) {
        pg8::Gemm g{(const bf16*)(ws + WS_MIX), (const bf16*)(ws + WS_WO), M, D, D}; pg8::StaticOrder S; S.init(M, D, F.G, (int)blockIdx.x);
        pg8::EpiResid E{args.in[0], args.out, (bf16*)(ws + WS_XN), (float*)(ws + WS_SS1), D};
        pg8::gemm_phase<pg8::EpiResid, pg8::StaticOrder, PG8_ALIGN, PG8_SP2>(F.lds + RING_OFF, g, S, E);
    } SEAM(3);
    if (IN(4)) for (int rep = 0; rep < REP4; ++rep) {
        pg8::Gemm g{(const bf16*)(ws + WS_XN), (const bf16*)(ws + WS_W1), M, FF, D}; pg8::StaticOrder S; S.init(M, FF, F.G, (int)blockIdx.x);
        pg8::EpiSqRelu E{(bf16*)(ws + WS_U), FF, (const float*)(ws + WS_SS1)};
        pg8::gemm_phase<pg8::EpiSqRelu, pg8::StaticOrder, PG8_ALIGN, PG8_SP2>(F.lds + RING_OFF, g, S, E);
    } SEAM(4);
    if (IN(5) && REP5 > 1) {
        pg8::Gemm g{(const bf16*)(ws + WS_U), (const bf16*)(ws + WS_W2), M, D, FF}; pg8::StaticOrder S; S.init(M, D, F.G, (int)blockIdx.x);
        pg8::EpiResid E{args.out, (float*)(ws + 352 * MiB), nullptr, (float*)(ws + 512 * 1024), D};
        pg8::gemm_phase<pg8::EpiResid, pg8::StaticOrder, PG8_ALIGN, PG8_SP2>(F.lds + RING_OFF, g, S, E);
    }
    if (IN(5)) {
        pg8::Gemm g{(const bf16*)(ws + WS_U), (const bf16*)(ws + WS_W2), M, D, FF}; pg8::StaticOrder S; S.init(M, D, F.G, (int)blockIdx.x);
        pg8::EpiResid E{args.out, args.out, nullptr, (float*)(ws + WS_SS2), D};
        pg8::gemm_phase<pg8::EpiResid, pg8::StaticOrder, PG8_ALIGN, PG8_SP2>(F.lds + RING_OFF, g, S, E);
    } SEAM(5);
    if (IN(6) && REP6 > 1) { p6_final(F, args, (float*)(ws + 352 * MiB)); }
    if (IN(6)) { p6_final(F, args, args.out); }
#undef IN
#undef SEAM
}

extern "C" void kernel_launch(void* const* d_in, const int* in_sizes, int n_in, void* d_out, int out_size, void* d_ws, size_t ws_size, hipStream_t stream) {
    static int grid = 0;
    if (grid == 0) {
        if (n_in != 14 || in_sizes[0] != M * D || out_size != M * D || ws_size < WS_END) { fprintf(stderr, "kernel_launch: unexpected shapes (n_in %d, in0 %d, out %d, ws %zu)\n", n_in, n_in > 0 ? in_sizes[0] : -1, out_size, ws_size); grid = -1; return; }
        int dev = 0, cus = 0;
        if (hipGetDevice(&dev) != hipSuccess || hipDeviceGetAttribute(&cus, hipDeviceAttributeMultiprocessorCount, dev) != hipSuccess) { grid = -1; return; }
        if (hipFuncSetAttribute((const void*)fwd, hipFuncAttributeMaxDynamicSharedMemorySize, LDS_BYTES) != hipSuccess) { fprintf(stderr, "kernel_launch: hipFuncSetAttribute failed\n"); grid = -1; return; }
        grid = cus;
    }
    if (grid < 0) return;
    (void)hipMemsetAsync((char*)d_ws + WS_CTL, 0, CTL_ZERO_BYTES, stream);
    Args a{};
    for (int i = 0; i < 14; ++i) a.in[i] = (const float*)d_in[i];
    a.out = (float*)d_out; a.ws = (unsigned char*)d_ws; a.coop = 0; a.pad = 0;
    unsigned char* ws = (unsigned char*)d_ws;
    a.ph_lo = 0; a.ph_hi = 7; a.coop = 1;
    void* kargs[] = {&a};
    hipError_t e = hipLaunchCooperativeKernel((const void*)fwd, dim3(grid), dim3(NWAVES * 64), kargs, LDS_BYTES, stream);
    if (e != hipSuccess) fprintf(stderr, "kernel_launch: cooperative launch failed: %s (grid %d)\n", hipGetErrorString(e), grid);
}
```

```cpp
#include <hip/hip_runtime.h>
#include <hip/hip_cooperative_groups.h>
#include <cstdio>
#include <cstdint>
namespace cg = cooperative_groups;
namespace pg8 {
#define PG8_LAS __attribute__((address_space(3)))
typedef unsigned short bf16_t;
typedef short bf16x8 __attribute__((ext_vector_type(8)));
typedef float f32x4 __attribute__((ext_vector_type(4)));
typedef unsigned u32x4 __attribute__((ext_vector_type(4)));
constexpr int BM = 256, BK = 64, HALF = 128, HTB = HALF * BK * 2  , STAGE_BYTES = 8 * HTB, NXCD = 8, WGM = 8;

__host__ __device__ __forceinline__ int lds_byte(int r, int c) { const int st = (r >> 4) * 2 + (c >> 5), rr = r & 15, cc = c & 31, ob = rr * 64 + cc * 2; return st * 1024 + (ob ^ (((ob >> 9) & 1) << 5)); }
__host__ __device__ __forceinline__ void stage_rc(int b, int& R, int& C) { const int st = b / 1024, sb = b % 1024, swz = sb ^ (((sb >> 9) & 1) << 5); R = (st >> 1) * 16 + swz / 64; C = (st & 1) * 32 + (swz % 64) / 2; }
__host__ __device__ __forceinline__ int perm32(int rho) { const int n = rho >> 4, i = rho & 15; return 8 * (i >> 2) + 4 * n + (i & 3); }

struct Unit { int pm, pn; };
struct Gemm { const bf16_t* A; const bf16_t* Bt; int M, N, K; };

struct StaticOrder {
    int nM, nN, nwg, G, c;
    __host__ __device__ void init(int M, int N, int G_, int c_) { nM = M / BM; nN = N / BM; nwg = nM * nN; G = G_; c = c_; }
    __host__ __device__ bool next(int i, Unit& u) const {
        const long L = (long)i * G + c; if (L >= nwg) return false;
        int wgid = (int)L; { const int q = nwg / NXCD, r = nwg % NXCD, xcd = wgid % NXCD, off = wgid / NXCD; wgid = (xcd < r ? xcd * (q + 1) : r * (q + 1) + (xcd - r) * q) + off; }
        const int nig = WGM * nN, gid = wgid / nig, fm = gid * WGM, gsz = (nM - fm) < WGM ? (nM - fm) : WGM;
        u.pm = fm + ((wgid % nig) % gsz); u.pn = (wgid % nig) / gsz; return true;
    }
    __device__ __forceinline__ void a_ready(const Unit&) const {}
    __device__ __forceinline__ void done(const Unit&) const {}
};

__device__ __forceinline__ unsigned cvt_pk_bf16(float lo, float hi) { unsigned r; asm volatile("v_cvt_pk_bf16_f32 %0, %1, %2" : "=v"(r) : "v"(lo), "v"(hi)); return r; }
typedef unsigned u32x2 __attribute__((ext_vector_type(2)));
struct EpiBf16Plain {
    static constexpr bool PERM = true, AFTER_DRAIN = false;
    bf16_t* O; int ldc;
    __device__ __forceinline__ void operator()(const f32x4 (&acc)[2][2][4][2], const Unit& u, int wr, int wc, int fr, int fq) const {
        const int row0 = u.pm * BM + wr * 64 + fr; const int col0 = u.pn * BM + wc * 32 + 8 * fq;
#pragma unroll
        for (int ai = 0; ai < 2; ++ai)
#pragma unroll
            for (int m = 0; m < 4; ++m) { bf16_t* rowp = O + (size_t)(row0 + ai * HALF + m * 16) * ldc + col0;
#pragma unroll
                for (int bj = 0; bj < 2; ++bj) { const f32x4 v0 = acc[ai][bj][m][0], v1 = acc[ai][bj][m][1];
                    u32x4 w; w.x = cvt_pk_bf16(v0[0], v0[1]); w.y = cvt_pk_bf16(v0[2], v0[3]); w.z = cvt_pk_bf16(v1[0], v1[1]); w.w = cvt_pk_bf16(v1[2], v1[3]);
                    *(u32x4*)(rowp + bj * HALF) = w; } }
    }
};
struct EpiSqRelu {
    static constexpr bool PERM = true, AFTER_DRAIN = false;
    bf16_t* O; int ldc; const float* ss;
    __device__ __forceinline__ void operator()(const f32x4 (&acc)[2][2][4][2], const Unit& u, int wr, int wc, int fr, int fq) const {
        const int row0 = u.pm * BM + wr * 64 + fr; const int col0 = u.pn * BM + wc * 32 + 8 * fq;
#pragma unroll
        for (int ai = 0; ai < 2; ++ai)
#pragma unroll
            for (int m = 0; m < 4; ++m) { const int row = row0 + ai * HALF + m * 16; bf16_t* rowp = O + (size_t)row * ldc + col0;
                const float sv = __hip_atomic_load(ss + row, __ATOMIC_RELAXED, __HIP_MEMORY_SCOPE_AGENT);
                const float inv = rsqrtf(sv * (1.0f / 1024.0f) + 1e-6f), inv2 = inv * inv;
#pragma unroll
                for (int bj = 0; bj < 2; ++bj) { f32x4 v0 = acc[ai][bj][m][0], v1 = acc[ai][bj][m][1];
#pragma unroll
                    for (int e = 0; e < 4; ++e) { const float a = fmaxf(v0[e], 0.f), b = fmaxf(v1[e], 0.f); v0[e] = a * a * inv2; v1[e] = b * b * inv2; }
                    u32x4 w; w.x = cvt_pk_bf16(v0[0], v0[1]); w.y = cvt_pk_bf16(v0[2], v0[3]); w.z = cvt_pk_bf16(v1[0], v1[1]); w.w = cvt_pk_bf16(v1[2], v1[3]);
                    *(u32x4*)(rowp + bj * HALF) = w; } }
    }
};
struct EpiResid {
    static constexpr bool PERM = false, AFTER_DRAIN = false;
    const float* base; float* out; bf16_t* ob; float* ss; int ldc;
    __device__ __forceinline__ void operator()(const f32x4 (&acc)[2][2][4][2], const Unit& u, int wr, int wc, int fr, int fq) const {
        const int col0 = u.pn * BM + wc * 32 + 4 * fq;
#pragma unroll
        for (int ai = 0; ai < 2; ++ai)
#pragma unroll
            for (int m = 0; m < 4; ++m) { const int r = u.pm * BM + ai * HALF + wr * 64 + m * 16 + fr; const size_t off = (size_t)r * ldc + col0; float s = 0.f;
#pragma unroll
                for (int bj = 0; bj < 2; ++bj)
#pragma unroll
                    for (int n = 0; n < 2; ++n) { const f32x4 bs = *(const f32x4*)(base + off + bj * HALF + n * 16); const f32x4 o = bs + acc[ai][bj][m][n];
                        *(f32x4*)(out + off + bj * HALF + n * 16) = o; s += (o[0] * o[0] + o[1] * o[1]) + (o[2] * o[2] + o[3] * o[3]);
                        if (ob) { u32x2 w; w.x = cvt_pk_bf16(o[0], o[1]); w.y = cvt_pk_bf16(o[2], o[3]); *(u32x2*)(ob + off + bj * HALF + n * 16) = w; } }
                s += __shfl_xor(s, 16); s += __shfl_xor(s, 32);
                if (fq == 0) (void)__hip_atomic_fetch_add(ss + r, s, __ATOMIC_RELAXED, __HIP_MEMORY_SCOPE_AGENT); }
    }
};
template <bool BASE_F32> struct EpiResidB {
    static constexpr bool PERM = true, AFTER_DRAIN = false;
    const void* base; bf16_t* out; float* ss; int ldc;
    __device__ __forceinline__ void operator()(const f32x4 (&acc)[2][2][4][2], const Unit& u, int wr, int wc, int fr, int fq) const {
        const int row0 = u.pm * BM + wr * 64 + fr; const int col0 = u.pn * BM + wc * 32 + 8 * fq;
#pragma unroll
        for (int ai = 0; ai < 2; ++ai)
#pragma unroll
            for (int m = 0; m < 4; ++m) { const int row = row0 + ai * HALF + m * 16; const size_t off = (size_t)row * ldc + col0; float s = 0.f;
#pragma unroll
                for (int bj = 0; bj < 2; ++bj) { f32x4 v0 = acc[ai][bj][m][0], v1 = acc[ai][bj][m][1];
                    if (BASE_F32) { const float* bp = (const float*)base + off + bj * HALF; v0 += *(const f32x4*)bp; v1 += *(const f32x4*)(bp + 4); }
                    else { const u32x4 bw = *(const u32x4*)((const bf16_t*)base + off + bj * HALF);
                        v0[0] += __builtin_bit_cast(float, bw.x << 16); v0[1] += __builtin_bit_cast(float, bw.x & 0xffff0000u); v0[2] += __builtin_bit_cast(float, bw.y << 16); v0[3] += __builtin_bit_cast(float, bw.y & 0xffff0000u);
                        v1[0] += __builtin_bit_cast(float, bw.z << 16); v1[1] += __builtin_bit_cast(float, bw.z & 0xffff0000u); v1[2] += __builtin_bit_cast(float, bw.w << 16); v1[3] += __builtin_bit_cast(float, bw.w & 0xffff0000u); }
                    s += ((v0[0] * v0[0] + v0[1] * v0[1]) + (v0[2] * v0[2] + v0[3] * v0[3])) + ((v1[0] * v1[0] + v1[1] * v1[1]) + (v1[2] * v1[2] + v1[3] * v1[3]));
                    u32x4 w; w.x = cvt_pk_bf16(v0[0], v0[1]); w.y = cvt_pk_bf16(v0[2], v0[3]); w.z = cvt_pk_bf16(v1[0], v1[1]); w.w = cvt_pk_bf16(v1[2], v1[3]);
                    *(u32x4*)(out + off + bj * HALF) = w; }
                s += __shfl_xor(s, 16); s += __shfl_xor(s, 32);
                if (fq == 0) (void)__hip_atomic_fetch_add(ss + row, s, __ATOMIC_RELAXED, __HIP_MEMORY_SCOPE_AGENT); }
    }
};

template <class Epi, class Sched, bool ALIGN_EPI = false, bool SP2 = false>
__device__ __forceinline__ void gemm_phase(PG8_LAS unsigned char* lds, const Gemm g, const Sched& S, const Epi& E) {
    const int tid = threadIdx.x, wid = __builtin_amdgcn_readfirstlane(tid >> 6), lane = tid & 63, wr = wid >> 2, wc = wid & 3, fr = lane & 15, fq = lane >> 4;
    const int K = g.K, nt = K / BK;
    unsigned voffA[2], voffB[2];
#pragma unroll
    for (int i = 0; i < 2; ++i) { int R, C; stage_rc(tid * 16 + i * 8192, R, C); const int Rb = Epi::PERM ? ((R & ~31) + perm32(R & 31)) : R;
        voffA[i] = (unsigned)(R * K + C) * 2u; voffB[i] = (unsigned)(Rb * K + C) * 2u; }
    const size_t kstep = (size_t)(BK * 2);
    const size_t hstep = (size_t)HALF * K * 2;
    const size_t tstep = 2 * hstep;
    const unsigned ldsw = (unsigned)wid * 1024u;
    const int aoff = lds_byte(wr * 64 + fr, fq * 8), boff = lds_byte(wc * 32 + fr, fq * 8);
#define PG8_SA(b, h) (((b) * 2 + (h)) * HTB)
#define PG8_SB(b, h) ((4 + (b) * 2 + (h)) * HTB)
#define PG8_STAGE(bufoff, gbase, voff) do { _Pragma("unroll") for (int _i = 0; _i < 2; ++_i) \
        __builtin_amdgcn_global_load_lds((const unsigned*)((const char*)(gbase) + (voff)[_i]), (PG8_LAS unsigned*)(lds + (bufoff) + ldsw + _i * 8192), 16, 0, 0); } while (0)
#define PG8_LDA(dst, b, h) do { _Pragma("unroll") for (int m = 0; m < 4; ++m) _Pragma("unroll") for (int k = 0; k < 2; ++k) dst[m][k] = *(const PG8_LAS bf16x8*)(lds + PG8_SA(b, h) + aoff + m * 2048 + k * 1024); } while (0)
#define PG8_LDB(dst, b, h) do { _Pragma("unroll") for (int n = 0; n < 2; ++n) _Pragma("unroll") for (int k = 0; k < 2; ++k) dst[n][k] = *(const PG8_LAS bf16x8*)(lds + PG8_SB(b, h) + boff + n * 2048 + k * 1024); } while (0)
#define PG8_MMA(ai, bj, At, Bt) do { __builtin_amdgcn_s_setprio(1); _Pragma("unroll") for (int m = 0; m < 4; ++m) _Pragma("unroll") for (int n = 0; n < 2; ++n) _Pragma("unroll") for (int k = 0; k < 2; ++k) \
        acc[ai][bj][m][n] = __builtin_amdgcn_mfma_f32_16x16x32_bf16(Bt[n][k], At[m][k], acc[ai][bj][m][n], 0, 0, 0); __builtin_amdgcn_s_setprio(0); } while (0)
#define PG8_WAIT_V(n) asm volatile("s_waitcnt vmcnt(" #n ")" ::: "memory")
#define PG8_WAIT_L(n) asm volatile("s_waitcnt lgkmcnt(" #n ")" ::: "memory")
#define PG8_BAR __builtin_amdgcn_s_barrier()
#define PG8_SCHED __builtin_amdgcn_sched_barrier(0)
    Unit cur, nxt; int ui = 0;
    if (!S.next(0, cur)) return;
    f32x4 acc[2][2][4][2];
#pragma unroll
    for (int a = 0; a < 2; ++a)
#pragma unroll
        for (int b = 0; b < 2; ++b)
#pragma unroll
            for (int m = 0; m < 4; ++m)
#pragma unroll
                for (int n = 0; n < 2; ++n) acc[a][b][m][n] = (f32x4){0.f, 0.f, 0.f, 0.f};
    bf16x8 At[4][2], B0[2][2], B1[2][2];
    const char* cA = (const char*)g.A + (size_t)cur.pm * tstep; const char* cB = (const char*)g.Bt + (size_t)cur.pn * tstep;
    S.a_ready(cur);
    if constexpr (SP2) {
        PG8_STAGE(PG8_SB(0, 0), cB, voffB); PG8_STAGE(PG8_SB(0, 1), cB + hstep, voffB); PG8_STAGE(PG8_SA(0, 0), cA, voffA); PG8_STAGE(PG8_SA(0, 1), cA + hstep, voffA);
        if (wr == 1) PG8_BAR;
        PG8_WAIT_V(2); PG8_BAR;
        PG8_STAGE(PG8_SB(1, 0), cB + kstep, voffB); PG8_STAGE(PG8_SA(1, 0), cA + kstep, voffA); PG8_STAGE(PG8_SB(1, 1), cB + hstep + kstep, voffB);
        PG8_WAIT_V(6); PG8_BAR;
    } else {
        PG8_STAGE(PG8_SB(0, 0), cB, voffB); PG8_STAGE(PG8_SA(0, 0), cA, voffA); PG8_STAGE(PG8_SB(0, 1), cB + hstep, voffB); PG8_STAGE(PG8_SA(0, 1), cA + hstep, voffA);
        if (wr == 1) PG8_BAR;
        PG8_WAIT_V(4); PG8_BAR;
        PG8_STAGE(PG8_SB(1, 0), cB + kstep, voffB); PG8_STAGE(PG8_SA(1, 0), cA + kstep, voffA); PG8_STAGE(PG8_SB(1, 1), cB + hstep + kstep, voffB);
        PG8_WAIT_V(6); PG8_BAR;
    }
    for (;;) {
        const bool has_next = S.next(ui + 1, nxt);
        const char* nA = has_next ? (const char*)g.A + (size_t)nxt.pm * tstep : cA; const char* nB = has_next ? (const char*)g.Bt + (size_t)nxt.pn * tstep : cB;
        for (int t = 0; t < nt; t += 2) {
            const bool last = (t == nt - 2);
            const char* a1 = cA + (size_t)(t + 1) * kstep;
            const char* a2 = last ? nA : cA + (size_t)(t + 2) * kstep; const char* b2 = last ? nB : cB + (size_t)(t + 2) * kstep;
            const char* a3 = a2 + kstep; const char* b3 = b2 + kstep;
            if (last && has_next) S.a_ready(nxt);
            if constexpr (SP2) {
            PG8_LDB(B0, 0, 0); PG8_LDB(B1, 0, 1); PG8_SCHED; PG8_LDA(At, 0, 0); PG8_STAGE(PG8_SA(1, 1), a1 + hstep, voffA);
            PG8_WAIT_V(8); PG8_WAIT_L(0); PG8_BAR; PG8_MMA(0, 0, At, B0); PG8_MMA(0, 1, At, B1); PG8_BAR; PG8_SCHED;
            PG8_LDA(At, 0, 1); PG8_STAGE(PG8_SB(0, 0), b2, voffB); PG8_STAGE(PG8_SB(0, 1), b2 + hstep, voffB); PG8_STAGE(PG8_SA(0, 0), a2, voffA);
            PG8_WAIT_V(8); PG8_WAIT_L(0); PG8_BAR; PG8_MMA(1, 0, At, B0); PG8_MMA(1, 1, At, B1); PG8_BAR; PG8_SCHED;
            PG8_LDB(B0, 1, 0); PG8_LDB(B1, 1, 1); PG8_SCHED; PG8_LDA(At, 1, 0); PG8_STAGE(PG8_SA(0, 1), a2 + hstep, voffA);
            PG8_WAIT_V(8); PG8_WAIT_L(0); PG8_BAR; PG8_MMA(0, 0, At, B0); PG8_MMA(0, 1, At, B1); PG8_BAR; PG8_SCHED;
            PG8_LDA(At, 1, 1); PG8_STAGE(PG8_SB(1, 0), b3, voffB); PG8_STAGE(PG8_SB(1, 1), b3 + hstep, voffB); PG8_STAGE(PG8_SA(1, 0), a3, voffA);
            PG8_WAIT_V(8); PG8_WAIT_L(0); PG8_BAR; PG8_MMA(1, 0, At, B0); PG8_MMA(1, 1, At, B1); PG8_BAR; PG8_SCHED;
            } else {
            PG8_LDB(B0, 0, 0); PG8_SCHED; PG8_LDA(At, 0, 0); PG8_STAGE(PG8_SA(1, 1), a1 + hstep, voffA);
            PG8_WAIT_L(8); PG8_BAR; PG8_WAIT_L(0); PG8_MMA(0, 0, At, B0); PG8_BAR; PG8_SCHED;
            PG8_LDB(B1, 0, 1); PG8_STAGE(PG8_SB(0, 0), b2, voffB);
            PG8_BAR; PG8_WAIT_L(0); PG8_MMA(0, 1, At, B1); PG8_BAR;
            PG8_LDA(At, 0, 1); PG8_STAGE(PG8_SA(0, 0), a2, voffA);
            PG8_BAR; PG8_WAIT_L(0); PG8_MMA(1, 0, At, B0); PG8_BAR; PG8_SCHED;
            PG8_STAGE(PG8_SB(0, 1), b2 + hstep, voffB);
            PG8_WAIT_V(6); PG8_BAR; PG8_MMA(1, 1, At, B1); PG8_BAR;
            PG8_LDB(B0, 1, 0); PG8_SCHED; PG8_LDA(At, 1, 0); PG8_STAGE(PG8_SA(0, 1), a2 + hstep, voffA);
            PG8_WAIT_L(8); PG8_BAR; PG8_WAIT_L(0); PG8_MMA(0, 0, At, B0); PG8_BAR; PG8_SCHED;
            PG8_LDB(B1, 1, 1); PG8_STAGE(PG8_SB(1, 0), b3, voffB);
            PG8_BAR; PG8_WAIT_L(0); PG8_MMA(0, 1, At, B1); PG8_BAR;
            PG8_LDA(At, 1, 1); PG8_STAGE(PG8_SA(1, 0), a3, voffA);
            PG8_BAR; PG8_WAIT_L(0); PG8_MMA(1, 0, At, B0); PG8_BAR; PG8_SCHED;
            PG8_STAGE(PG8_SB(1, 1), b3 + hstep, voffB);
            PG8_WAIT_V(6); PG8_BAR; PG8_MMA(1, 1, At, B1); PG8_BAR;
            }
        }
        if constexpr (ALIGN_EPI) { if (wr == 0) PG8_BAR; }
        if constexpr (!Epi::AFTER_DRAIN) { E(acc, cur, wr, wc, fr, fq); S.done(cur); }
        if (!has_next) break;
#pragma unroll
        for (int a = 0; a < 2; ++a)
#pragma unroll
            for (int b = 0; b < 2; ++b)
#pragma unroll
                for (int m = 0; m < 4; ++m)
#pragma unroll
                    for (int n = 0; n < 2; ++n) acc[a][b][m][n] = (f32x4){0.f, 0.f, 0.f, 0.f};
        cur = nxt; cA = nA; cB = nB; ++ui;
        if constexpr (ALIGN_EPI) { if (wr == 1) PG8_BAR; }
    }
    PG8_WAIT_V(0);
    if constexpr (!ALIGN_EPI) { if (wr == 0) PG8_BAR; }
    PG8_BAR;
    if constexpr (Epi::AFTER_DRAIN) { E.fused(acc, cur, wr, wc, fr, fq, lds, wid, lane); S.done(cur); }
#undef PG8_SA
#undef PG8_SB
#undef PG8_STAGE
#undef PG8_LDA
#undef PG8_LDB
#undef PG8_MMA
#undef PG8_WAIT_V
#undef PG8_WAIT_L
#undef PG8_BAR
#undef PG8_SCHED
}
}
#ifndef PG8_SP2
#define PG8_SP2 true
#endif
#ifndef PG8_ALIGN
#define PG8_ALIGN true
#endif
constexpr int NWAVES = 8;
constexpr int BATCH = 16, SEQ = 2048, D = 1024, FF = 4096, NPROJ = 3072;
constexpr int M = BATCH * SEQ;
constexpr float EPS = 1e-6f;
constexpr int C_DQ = 0, C_DK = 512, C_DV = 1024, C_SQ = 1536, C_SK = 2048, C_SV = 2560;
constexpr size_t MiB = 1u << 20;
constexpr size_t WS_CTL = 0, CTL_ZERO_BYTES = 1 * MiB;
constexpr size_t WS_SS1 = 0, WS_SS2 = 256 * 1024;
constexpr size_t WS_WQKV = 2 * MiB, WS_WO = 8 * MiB, WS_W1 = 10 * MiB, WS_W2 = 18 * MiB;
constexpr size_t WS_XN = 32 * MiB;
constexpr size_t WS_PROJ = 96 * MiB;
constexpr size_t WS_MIX = 288 * MiB;
constexpr size_t WS_U = 96 * MiB;
constexpr size_t WS_END = 352 * MiB;
constexpr int RING_OFF = 0, RING_BYTES = 131072;
constexpr int LDS_BYTES = 147456;

#define GAS __attribute__((address_space(1)))
#define LAS __attribute__((address_space(3)))
typedef unsigned short bf16;
typedef unsigned v4u __attribute__((ext_vector_type(4)));
typedef float f32x4 __attribute__((ext_vector_type(4)));
#define LDS_WAIT() asm volatile("s_waitcnt lgkmcnt(0)" ::: "memory")
__device__ __forceinline__ unsigned f2bf(float f) { unsigned u = __builtin_bit_cast(unsigned, f); return (u + 0x7fffu + ((u >> 16) & 1u)) >> 16; }
__device__ __forceinline__ unsigned pk2(float lo, float hi) { return f2bf(lo) | (f2bf(hi) << 16); }
__device__ __forceinline__ float bflo(unsigned w) { return __builtin_bit_cast(float, w << 16); }
__device__ __forceinline__ float bfhi(unsigned w) { return __builtin_bit_cast(float, w & 0xffff0000u); }

struct Frame {
    LAS unsigned char* lds;
    int tid, lane, wave, vcu, G;
};
__device__ __forceinline__ float wave_sum(float v) {
#pragma unroll
    for (int o = 1; o < 64; o <<= 1) v += __shfl_xor(v, o);
    return v;
}
__device__ __forceinline__ void p0_transpose_item(const float* W, int K, int N, bf16* WT, const float* ks, LAS float* scr, int item, int lane) {
    const int nblk = N / 32, kb = item / nblk, nb = item % nblk, k0 = 64 * kb, n0 = 32 * nb;
#pragma unroll 8
    for (int i = 0; i < 32; ++i) { const int kk = 2 * i + (lane >> 5); float v = W[(size_t)(k0 + kk) * N + n0 + (lane & 31)]; if (ks) v *= ks[k0 + kk]; scr[kk * 33 + (lane & 31)] = v; }
    LDS_WAIT(); asm volatile("" ::: "memory");
    const int c = lane & 7;
#pragma unroll
    for (int j = 0; j < 4; ++j) { const int n = (lane >> 3) + 8 * j; const LAS float* s = scr + (8 * c) * 33 + n;
        v4u o; o.x = pk2(s[0 * 33], s[1 * 33]); o.y = pk2(s[2 * 33], s[3 * 33]); o.z = pk2(s[4 * 33], s[5 * 33]); o.w = pk2(s[6 * 33], s[7 * 33]);
        *(GAS v4u*)(WT + (size_t)(n0 + n) * K + k0 + 8 * c) = o; }
    LDS_WAIT(); asm volatile("" ::: "memory");
}
__device__ __forceinline__ void rms_row_to_bf16(int lane, const float* xrow, const float* g, bf16* orow) {
    const GAS f32x4* xr = (const GAS f32x4*)xrow + lane; const GAS f32x4* gr = (const GAS f32x4*)g + lane;
    f32x4 v[4]; float s = 0.f;
#pragma unroll
    for (int j = 0; j < 4; ++j) { v[j] = xr[64 * j]; s += (v[j].x * v[j].x + v[j].y * v[j].y) + (v[j].z * v[j].z + v[j].w * v[j].w); }
    const float inv = rsqrtf(wave_sum(s) * (1.f / D) + EPS);
    GAS unsigned long long* o8 = (GAS unsigned long long*)orow + lane;
#pragma unroll
    for (int j = 0; j < 4; ++j) { const f32x4 gg = gr[64 * j];
        o8[64 * j] = (unsigned long long)pk2(v[j].x * inv * gg.x, v[j].y * inv * gg.y) | ((unsigned long long)pk2(v[j].z * inv * gg.z, v[j].w * inv * gg.w) << 32); }
}
struct Args { const float* in[14]; float* out; unsigned char* ws; int ph_lo, ph_hi, coop, pad; };

__device__ __forceinline__ void p0_prologue(Frame& F, const Args& a) {
    LAS float* scr = (LAS float*)(F.lds + RING_OFF + F.wave * 16384);
    const int gw = F.vcu * NWAVES + F.wave, NGW = F.G * NWAVES;
    unsigned char* ws = a.ws;
    constexpr int I_IN = (D / 64) * (NPROJ / 32), I_O = (D / 64) * (D / 32), I_1 = (D / 64) * (FF / 32), I_2 = (FF / 64) * (D / 32);
    constexpr int NITEMS = I_IN + I_O + I_1 + I_2;
    for (int it = gw; it < NITEMS; it += NGW) {
        int r = it;
        if (r < I_IN) { p0_transpose_item(a.in[2], D, NPROJ, (bf16*)(ws + WS_WQKV), nullptr, scr, r, F.lane); continue; } r -= I_IN;
        if (r < I_O) { p0_transpose_item(a.in[9], D, D, (bf16*)(ws + WS_WO), nullptr, scr, r, F.lane); continue; } r -= I_O;
        if (r < I_1) { p0_transpose_item(a.in[11], D, FF, (bf16*)(ws + WS_W1), a.in[10], scr, r, F.lane); continue; } r -= I_1;
        p0_transpose_item(a.in[12], FF, D, (bf16*)(ws + WS_W2), nullptr, scr, r, F.lane);
    }
    for (int m = gw; m < M; m += NGW) rms_row_to_bf16(F.lane, a.in[0] + (size_t)m * D, a.in[1], (bf16*)(ws + WS_XN) + (size_t)m * D);
}
__device__ __forceinline__ void p6_final(Frame& F, const Args& a, float* dst) {
    const int gw = F.vcu * NWAVES + F.wave, NGW = F.G * NWAVES;
    const float* ss2 = (const float*)(a.ws + WS_SS2); const bf16* hb = (const bf16*)(a.ws + WS_XN);
    f32x4 gg[4];
#pragma unroll
    for (int j = 0; j < 2; ++j) { gg[2 * j] = *(const GAS f32x4*)(a.in[13] + 512 * j + 8 * F.lane); gg[2 * j + 1] = *(const GAS f32x4*)(a.in[13] + 512 * j + 8 * F.lane + 4); }
    for (int m = gw; m < M; m += 2 * NGW) {
        const int m2 = m + NGW;
        v4u w[2][2];
#pragma unroll
        for (int j = 0; j < 2; ++j) { w[0][j] = *(const GAS v4u*)(hb + (size_t)m * D + 512 * j + 8 * F.lane); if (m2 < M) w[1][j] = *(const GAS v4u*)(hb + (size_t)m2 * D + 512 * j + 8 * F.lane); }
#pragma unroll
        for (int rr = 0; rr < 2; ++rr) { const int mm = rr ? m2 : m; if (mm >= M) break;
            const float inv = rsqrtf(__hip_atomic_load(ss2 + mm, __ATOMIC_RELAXED, __HIP_MEMORY_SCOPE_AGENT) * (1.f / D) + EPS);
#pragma unroll
            for (int j = 0; j < 2; ++j) { const v4u x = w[rr][j];
                f32x4 o0 = {bflo(x.x), bfhi(x.x), bflo(x.y), bfhi(x.y)}, o1 = {bflo(x.z), bfhi(x.z), bflo(x.w), bfhi(x.w)};
                o0 = o0 * inv * gg[2 * j]; o1 = o1 * inv * gg[2 * j + 1];
                GAS f32x4* op = (GAS f32x4*)(dst + (size_t)mm * D + 512 * j + 8 * F.lane); op[0] = o0; op[1] = o1; } }
    }
}
typedef unsigned u32x4g __attribute__((ext_vector_type(4)));
__device__ __forceinline__ float lam_of(const float* lq1, const float* lk1, const float* lq2, const float* lk2) {
    float s1 = 0.f, s2 = 0.f;
    for (int i = 0; i < 64; ++i) { s1 += lq1[i] * lk1[i]; s2 += lq2[i] * lk2[i]; }
    return __expf(s1) - __expf(s2) + 0.2f;
}
namespace mixer {
typedef short bf16x8 __attribute__((ext_vector_type(8)));
typedef short s16x4 __attribute__((ext_vector_type(4)));
typedef short v4i16_t __attribute__((ext_vector_type(4)));
typedef float f32x16 __attribute__((ext_vector_type(16)));
typedef unsigned u32x4 __attribute__((ext_vector_type(4)));
typedef unsigned u32x2 __attribute__((ext_vector_type(2)));
typedef float f32x2_t __attribute__((ext_vector_type(2))); typedef __bf16 bf16x2_t __attribute__((ext_vector_type(2)));
constexpr int KSTR = 144, KBUF = 64 * KSTR;
constexpr int VSTRD = 320, VBUFD = 64 * VSTRD;
constexpr int VSTRS = 192, VBUFS = 64 * VSTRS;
constexpr int OFF_K = 0, OFF_V = 2 * KBUF, OFF_CNT = OFF_V + 2 * VBUFD, OFF_O1 = OFF_CNT + 128;
static_assert(OFF_O1 + 65536 <= RING_BYTES, "mixer LDS map");
constexpr float LOG2E = 1.4426950408889634f, LN2 = 0.6931471805599453f;
__device__ __forceinline__ s16x4 vtr(const LAS unsigned char* p) { return __builtin_bit_cast(s16x4, __builtin_amdgcn_ds_read_tr16_b64_v4i16((LAS v4i16_t*)p)); }
__device__ __forceinline__ unsigned cvtpk(float lo, float hi) { f32x2_t v = {lo, hi}; bf16x2_t b = __builtin_convertvector(v, bf16x2_t); return __builtin_bit_cast(unsigned, b); }
__device__ __forceinline__ float xhalf(float v) { return __shfl_xor(v, 32); }
#define CROW(r) (((r) & 3) + 8 * ((r) >> 2))
__device__ __forceinline__ void qk_tile(f32x16& p0, f32x16& p1, const LAS unsigned char* Kt, const bf16x8 (&qr)[4], int r32, int hi) {
    const LAS unsigned char* kb = Kt + r32 * KSTR + hi * 16;
#pragma unroll
    for (int r = 0; r < 16; ++r) { p0[r] = 0.f; p1[r] = 0.f; }
#pragma unroll
    for (int d0 = 0; d0 < 4; ++d0) {
        const bf16x8 a0 = *(const LAS bf16x8*)(kb + d0 * 32), a1 = *(const LAS bf16x8*)(kb + 32 * KSTR + d0 * 32);
        p0 = __builtin_amdgcn_mfma_f32_32x32x16_bf16(a0, qr[d0], p0, 0, 0, 0); p1 = __builtin_amdgcn_mfma_f32_32x32x16_bf16(a1, qr[d0], p1, 0, 0, 0); }
}
template <int NB, int VSTR> __device__ __forceinline__ void pv_tile(f32x16 (&o)[NB], const LAS unsigned char* vb, const f32x16& p0, const f32x16& p1) {
    u32x4 pw[4];
#pragma unroll
    for (int e = 0; e < 4; ++e) { pw[0][e] = cvtpk(p0[2 * e], p0[2 * e + 1]); pw[1][e] = cvtpk(p0[8 + 2 * e], p0[9 + 2 * e]); pw[2][e] = cvtpk(p1[2 * e], p1[2 * e + 1]); pw[3][e] = cvtpk(p1[8 + 2 * e], p1[9 + 2 * e]); }
#pragma unroll
    for (int ks = 0; ks < 4; ++ks)
#pragma unroll
        for (int nb = 0; nb < NB; ++nb) {
            const s16x4 lo = vtr(vb + (ks * 16) * VSTR + nb * 64), hh = vtr(vb + (ks * 16 + 8) * VSTR + nb * 64);
            const bf16x8 vf = {lo[0], lo[1], lo[2], lo[3], hh[0], hh[1], hh[2], hh[3]};
            o[nb] = __builtin_amdgcn_mfma_f32_32x32x16_bf16(vf, __builtin_bit_cast(bf16x8, pw[ks]), o[nb], 0, 0, 0); }
}
__device__ __forceinline__ void diff_unit(LAS unsigned char* lds, const bf16* proj, bf16* mixo, int b, int h, int qb, float lam, const float* g) {
    const int tid = threadIdx.x, lane = tid & 63, r32 = lane & 31, hi = lane >> 5, wid = __builtin_amdgcn_readfirstlane(tid >> 6);
    const size_t rowb = (size_t)b * SEQ; const int q0 = qb * 256, qw0 = q0 + wid * 32, qpos = qw0 + r32, NT = (q0 + 256) / 64;
    const float slope2 = exp2f(-2.f * (float)(h + 1)) * LOG2E, C2 = 0.125f * LOG2E;
    const int krow = tid >> 3, kch = tid & 7, vrow = tid >> 4, vch = tid & 15;
    const int vlane = (4 * (lane >> 5) + ((lane & 15) >> 2)) * VSTRD + (16 * ((lane >> 4) & 1) + 4 * (lane & 3)) * 2;
    LAS unsigned* o1s = (LAS unsigned*)(lds + OFF_O1) + wid * 2048 + lane;
    f32x16 o[4];
    for (int map = 0; map < 2; ++map) {
        const bf16* Qp = proj + (rowb + qpos) * NPROJ + C_DQ + h * 128 + map * 64;
        const bf16* Kb = proj + rowb * NPROJ + C_DK + h * 128 + map * 64 + (size_t)krow * NPROJ + kch * 8;
        const bf16* Vb = proj + rowb * NPROJ + C_DV + h * 128 + (size_t)vrow * NPROJ + vch * 8;
        bf16x8 qr[4];
#pragma unroll
        for (int d0 = 0; d0 < 4; ++d0) qr[d0] = *(const bf16x8*)(Qp + 16 * d0 + 8 * hi);
#pragma unroll
        for (int nb = 0; nb < 4; ++nb)
#pragma unroll
            for (int r = 0; r < 16; ++r) o[nb][r] = 0.f;
        float mref = -1e30f, l = 0.f;
        u32x4 kreg = *(const u32x4*)(Kb), vreg0 = *(const u32x4*)(Vb), vreg1 = *(const u32x4*)(Vb + (size_t)32 * NPROJ);
        __syncthreads();
        *(LAS u32x4*)(lds + OFF_K + krow * KSTR + kch * 16) = kreg; *(LAS u32x4*)(lds + OFF_V + vrow * VSTRD + vch * 16) = vreg0; *(LAS u32x4*)(lds + OFF_V + (vrow + 32) * VSTRD + vch * 16) = vreg1;
        __syncthreads();
        for (int t = 0; t < NT; ++t) {
            const int buf = t & 1;
            if (t + 1 < NT) { const size_t go = (size_t)(64 * (t + 1)) * NPROJ; kreg = *(const u32x4*)(Kb + go); vreg0 = *(const u32x4*)(Vb + go); vreg1 = *(const u32x4*)(Vb + go + (size_t)32 * NPROJ); }
            if (64 * t <= qw0) {
                f32x16 p0, p1;
                qk_tile(p0, p1, lds + OFF_K + buf * KBUF, qr, r32, hi);
                const int di = qpos - 64 * t - 4 * hi; const float bb = -slope2 * (float)di;
                const bool diag = (64 * t + 63 > qw0);
                float rm = -INFINITY;
#pragma unroll
                for (int r = 0; r < 16; ++r) {
                    p0[r] = __builtin_fmaf(p0[r], C2, __builtin_fmaf(slope2, (float)CROW(r), bb)); p1[r] = __builtin_fmaf(p1[r], C2, __builtin_fmaf(slope2, (float)(CROW(r) + 32), bb));
                    if (diag) { if (CROW(r) > di) p0[r] = -INFINITY; if (CROW(r) + 32 > di) p1[r] = -INFINITY; }
                    rm = fmaxf(rm, fmaxf(p0[r], p1[r])); }
                rm = fmaxf(rm, xhalf(rm));
                if (__any(rm > mref + 8.f)) {
                    const float mn = fmaxf(mref, rm), al = __builtin_amdgcn_exp2f(mref - mn); mref = mn; l *= al;
#pragma unroll
                    for (int nb = 0; nb < 4; ++nb)
#pragma unroll
                        for (int r = 0; r < 16; ++r) o[nb][r] *= al; }
                float ps = 0.f;
#pragma unroll
                for (int r = 0; r < 16; ++r) { p0[r] = __builtin_amdgcn_exp2f(p0[r] - mref); p1[r] = __builtin_amdgcn_exp2f(p1[r] - mref); ps += p0[r] + p1[r]; }
                l += ps;
                pv_tile<4, VSTRD>(o, lds + OFF_V + buf * VBUFD + vlane, p0, p1);
            }
            if (t + 1 < NT) { const int nb_ = buf ^ 1; *(LAS u32x4*)(lds + OFF_K + nb_ * KBUF + krow * KSTR + kch * 16) = kreg;
                *(LAS u32x4*)(lds + OFF_V + nb_ * VBUFD + vrow * VSTRD + vch * 16) = vreg0; *(LAS u32x4*)(lds + OFF_V + nb_ * VBUFD + (vrow + 32) * VSTRD + vch * 16) = vreg1; }
            __syncthreads();
        }
        const float lt = l + xhalf(l);
        if (map == 0) { const float rl = 1.f / lt;
#pragma unroll
            for (int nb = 0; nb < 4; ++nb)
#pragma unroll
                for (int k = 0; k < 8; ++k) o1s[(nb * 8 + k) * 64] = cvtpk(o[nb][2 * k] * rl, o[nb][2 * k + 1] * rl);
        } else { const float rl2 = lam / lt; float ssq = 0.f;
#pragma unroll
            for (int nb = 0; nb < 4; ++nb)
#pragma unroll
                for (int k = 0; k < 8; ++k) { const unsigned ow = o1s[(nb * 8 + k) * 64]; const float a = bflo(ow) - o[nb][2 * k] * rl2, c = bfhi(ow) - o[nb][2 * k + 1] * rl2; o[nb][2 * k] = a; o[nb][2 * k + 1] = c; ssq += a * a + c * c; }
            ssq += xhalf(ssq);
            const float inv = rsqrtf(ssq * (1.f / 128.f) + EPS) * 0.8f;
            bf16* orow = mixo + (rowb + qpos) * D + h * 128 + 4 * hi;
#pragma unroll
            for (int nb = 0; nb < 4; ++nb)
#pragma unroll
                for (int gq = 0; gq < 4; ++gq) { const int d = 32 * nb + 8 * gq; const f32x4 gv = *(const f32x4*)(g + d + 4 * hi);
                    u32x2 w; w.x = cvtpk(o[nb][4 * gq] * inv * gv[0], o[nb][4 * gq + 1] * inv * gv[1]); w.y = cvtpk(o[nb][4 * gq + 2] * inv * gv[2], o[nb][4 * gq + 3] * inv * gv[3]);
                    *(u32x2*)(orow + d) = w; }
        }
    }
}
__device__ __forceinline__ void sb_unit(LAS unsigned char* lds, const bf16* proj, bf16* mixo, int b, int h, int qb, const float* g) {
    const int tid = threadIdx.x, lane = tid & 63, r32 = lane & 31, hi = lane >> 5, wid = __builtin_amdgcn_readfirstlane(tid >> 6);
    const size_t rowb = (size_t)b * SEQ; const int q0 = qb * 256, qw0 = q0 + wid * 32, qpos = qw0 + r32, NT = (q0 + 256) / 64;
    const int krow = tid >> 3, kch = tid & 7;
    const int vlane = (4 * (lane >> 5) + ((lane & 15) >> 2)) * VSTRS + (16 * ((lane >> 4) & 1) + 4 * (lane & 3)) * 2;
    LAS int* cnt = (LAS int*)(lds + OFF_CNT);
    const bf16* Qp = proj + (rowb + qpos) * NPROJ + C_SQ + h * 64;
    const bf16* Kb = proj + rowb * NPROJ + C_SK + h * 64 + (size_t)krow * NPROJ + kch * 8;
    const bf16* Vb = proj + rowb * NPROJ + C_SV + h * 64 + (size_t)krow * NPROJ + kch * 8;
    bf16x8 qr[4];
#pragma unroll
    for (int d0 = 0; d0 < 4; ++d0) qr[d0] = *(const bf16x8*)(Qp + 16 * d0 + 8 * hi);
    f32x16 o[2];
#pragma unroll
    for (int nb = 0; nb < 2; ++nb)
#pragma unroll
        for (int r = 0; r < 16; ++r) o[nb][r] = 0.f;
    float R = 0.f; bool done = false;
    { const size_t go = (size_t)(64 * (NT - 1)) * NPROJ; u32x4 kreg = *(const u32x4*)(Kb + go), vreg = *(const u32x4*)(Vb + go);
      __syncthreads();
      if (tid < 32) cnt[tid] = 0;
      *(LAS u32x4*)(lds + OFF_K + krow * KSTR + kch * 16) = kreg; *(LAS u32x4*)(lds + OFF_V + krow * VSTRS + kch * 16) = vreg;
      __syncthreads(); }
    for (int it = 0; it < NT; ++it) {
        const int t = NT - 1 - it, buf = it & 1;
        u32x4 kreg, vreg;
        if (it + 1 < NT) { const size_t go = (size_t)(64 * (t - 1)) * NPROJ; kreg = *(const u32x4*)(Kb + go); vreg = *(const u32x4*)(Vb + go); }
        if (64 * t <= qw0 && !done) {
            f32x16 p0, p1, m0, m1;
            qk_tile(p0, p1, lds + OFF_K + buf * KBUF, qr, r32, hi);
            const int di = qpos - 64 * t - 4 * hi;
#pragma unroll
            for (int r = 0; r < 16; ++r) {
                const float z0 = p0[r] * 0.125f, z1 = p1[r] * 0.125f;
                const float e0 = __builtin_amdgcn_exp2f(-fabsf(z0) * LOG2E), e1 = __builtin_amdgcn_exp2f(-fabsf(z1) * LOG2E);
                const float ls0 = fminf(z0, 0.f) - __builtin_amdgcn_logf(1.f + e0) * LN2, ls1 = fminf(z1, 0.f) - __builtin_amdgcn_logf(1.f + e1) * LN2;
                const bool v0 = CROW(r) < di, v1 = CROW(r) + 32 < di;
                p0[r] = v0 ? ls0 : -INFINITY; p1[r] = v1 ? ls1 : -INFINITY;
                m0[r] = v0 ? ls0 - z0 : 0.f; m1[r] = v1 ? ls1 - z1 : 0.f; }
            float b0[4], b1[4], c0[4], c1[4];
#pragma unroll
            for (int gq = 0; gq < 4; ++gq) { const float s0 = (m0[4 * gq] + m0[4 * gq + 1]) + (m0[4 * gq + 2] + m0[4 * gq + 3]), s1 = (m1[4 * gq] + m1[4 * gq + 1]) + (m1[4 * gq + 2] + m1[4 * gq + 3]);
                b0[gq] = xhalf(s0); b1[gq] = xhalf(s1); c0[gq] = s0 + b0[gq]; c1[gq] = s1 + b1[gq]; }
            const float tot1 = (c1[0] + c1[1]) + (c1[2] + c1[3]), tot0 = (c0[0] + c0[1]) + (c0[2] + c0[3]);
            float S0[4], S1[4];
            S1[3] = R; S1[2] = S1[3] + c1[3]; S1[1] = S1[2] + c1[2]; S1[0] = S1[1] + c1[1];
            S0[3] = R + tot1; S0[2] = S0[3] + c0[3]; S0[1] = S0[2] + c0[2]; S0[0] = S0[1] + c0[1];
#pragma unroll
            for (int gq = 0; gq < 4; ++gq) {
                float l0 = S0[gq] + (hi == 0 ? b0[gq] : 0.f), l1 = S1[gq] + (hi == 0 ? b1[gq] : 0.f);
#pragma unroll
                for (int e = 3; e >= 0; --e) { const int r = 4 * gq + e;
                    const float w0 = __builtin_amdgcn_exp2f((p0[r] + l0) * LOG2E), w1 = __builtin_amdgcn_exp2f((p1[r] + l1) * LOG2E);
                    l0 += m0[r]; l1 += m1[r]; p0[r] = w0; p1[r] = w1; } }
            R += tot0 + tot1;
            pv_tile<2, VSTRS>(o, lds + OFF_V + buf * VBUFS + vlane, p0, p1);
            done = __all(R < -110.f);
        }
        if (done && lane == 0) (void)__hip_atomic_fetch_add(cnt + it, 1, __ATOMIC_RELAXED, __HIP_MEMORY_SCOPE_WORKGROUP);
        if (it + 1 < NT) { const int nb_ = buf ^ 1; *(LAS u32x4*)(lds + OFF_K + nb_ * KBUF + krow * KSTR + kch * 16) = kreg; *(LAS u32x4*)(lds + OFF_V + nb_ * VBUFS + krow * VSTRS + kch * 16) = vreg; }
        __syncthreads();
        if (__hip_atomic_load(cnt + it, __ATOMIC_RELAXED, __HIP_MEMORY_SCOPE_WORKGROUP) == 8) break;
    }
    float ssq = 0.f;
#pragma unroll
    for (int nb = 0; nb < 2; ++nb)
#pragma unroll
        for (int r = 0; r < 16; ++r) ssq += o[nb][r] * o[nb][r];
    ssq += xhalf(ssq);
    const float inv = rsqrtf(ssq * (1.f / 64.f) + EPS);
    bf16* orow = mixo + (rowb + qpos) * D + 512 + h * 64 + 4 * hi;
#pragma unroll
    for (int nb = 0; nb < 2; ++nb)
#pragma unroll
        for (int gq = 0; gq < 4; ++gq) { const int d = 32 * nb + 8 * gq; const f32x4 gv = *(const f32x4*)(g + d + 4 * hi);
            u32x2 w; w.x = cvtpk(o[nb][4 * gq] * inv * gv[0], o[nb][4 * gq + 1] * inv * gv[1]); w.y = cvtpk(o[nb][4 * gq + 2] * inv * gv[2], o[nb][4 * gq + 3] * inv * gv[3]);
            *(u32x2*)(orow + d) = w; }
}
#undef CROW
}
#ifndef REP0
#define REP0 1
#endif
#ifndef REP1
#define REP1 1
#endif
#ifndef REP2D
#define REP2D 1
#endif
#ifndef REP2S
#define REP2S 1
#endif
#ifndef REP3
#define REP3 1
#endif
#ifndef REP5
#define REP5 1
#endif
#ifndef REP6
#define REP6 1
#endif
#ifndef REP4
#define REP4 1
#endif
typedef GAS unsigned gu32;
constexpr size_t WS_BAR = 768 * 1024;
constexpr int MISC_OFF = RING_BYTES + 320;
#define XB_TMO      128
#define XB_XCNT(j)  (256  + 64 * (j))
#define XB_XSUB(j)  (1280 + 64 * (j))
#define XB_XGEN(j)  (2304 + 64 * (j))
#define XB_TOP      3328
#define XB_TOPGEN   3392
#define XCD_BAR_WORDS 3456
#define XB_SPIN_CAP (1u << 18)

__device__ __forceinline__ unsigned xb_ld(unsigned* p)              { return __hip_atomic_load(p, __ATOMIC_RELAXED, __HIP_MEMORY_SCOPE_AGENT); }
__device__ __forceinline__ unsigned xb_add(unsigned* p, unsigned v) { return __hip_atomic_fetch_add(p, v, __ATOMIC_RELAXED, __HIP_MEMORY_SCOPE_AGENT); }
__device__ __forceinline__ unsigned xb_xcc_id() { return (unsigned)__builtin_amdgcn_s_getreg((3 << 11) | 20) & 0xFu; }
#define XB_SPIN(cond, bar) do { unsigned _sp = 0; while (cond) { __builtin_amdgcn_s_sleep(1); \
    if ((++_sp & 255u) == 0u) { if (xb_ld(&(bar)[XB_TMO])) break; if (_sp > XB_SPIN_CAP) { atomicAdd(&(bar)[XB_TMO], 1u); break; } } } } while (0)

struct XcdBarrier {
    unsigned* bar; unsigned x;
    volatile LAS unsigned* st;
};

__device__ __forceinline__ XcdBarrier xcd_barrier_post(unsigned* bar, volatile LAS unsigned* st) {
    XcdBarrier b; b.bar = bar; b.x = xb_xcc_id(); b.st = st;
    if (threadIdx.x == 0) (void)xb_add(&bar[XB_XCNT(b.x)], 1u);
    return b;
}
__device__ __forceinline__ void xcd_barrier_complete(unsigned* bar, unsigned x, unsigned& nloc, unsigned& nx) {
    const unsigned G = gridDim.x * gridDim.y * gridDim.z;
    unsigned sum, cnt, mine, sp = 0u;
    for (;;) {
        sum = 0u; cnt = 0u; mine = 0u;
#pragma unroll
        for (unsigned j = 0; j < 16; ++j) { const unsigned c = xb_ld(&bar[XB_XCNT(j)]); sum += c; cnt += (c > 0u) ? 1u : 0u; mine = (j == x) ? c : mine; }
        if (sum == G) break;
        __builtin_amdgcn_s_sleep(1);
        if ((++sp & 255u) == 0u) { if (xb_ld(&bar[XB_TMO])) break; if (sp > XB_SPIN_CAP) { atomicAdd(&bar[XB_TMO], 1u); break; } }
    }
    nloc = mine > 0u ? mine : 1u; nx = cnt > 0u ? cnt : 1u;
}

__device__ __forceinline__ void xcd_barrier(const XcdBarrier& b) {
    asm volatile("s_waitcnt vmcnt(0)" ::: "memory");
    __syncthreads();
    if (threadIdx.x == 0) {
        unsigned* bar = b.bar;
        __builtin_amdgcn_s_waitcnt(0);
        unsigned nloc = b.st[0], nx = b.st[1];
        if (nloc == 0u) { xcd_barrier_complete(bar, b.x, nloc, nx); b.st[0] = nloc; b.st[1] = nx; }
        const unsigned old = xb_add(&bar[XB_XSUB(b.x)], 1u);
        const unsigned gen = old / nloc;
        if (old + 1u == (gen + 1u) * nloc) {
            __builtin_amdgcn_fence(__ATOMIC_RELEASE, "agent");
            asm volatile("s_waitcnt vmcnt(0)" ::: "memory");
            const unsigned og = xb_add(&bar[XB_TOP], 1u);
            const unsigned tg = og / nx;
            if (og + 1u == (tg + 1u) * nx) xb_add(&bar[XB_TOPGEN], 1u);
            else XB_SPIN(xb_ld(&bar[XB_TOPGEN]) == tg, bar);
            __builtin_amdgcn_fence(__ATOMIC_ACQUIRE, "agent");
            xb_add(&bar[XB_XGEN(b.x)], 1u);
            asm volatile("s_waitcnt vmcnt(0)" ::: "memory");
        } else {
            XB_SPIN(xb_ld(&bar[XB_XGEN(b.x)]) == gen, bar);
            __builtin_amdgcn_fence(__ATOMIC_ACQUIRE, "agent");
            asm volatile("s_waitcnt vmcnt(0)" ::: "memory");
        }
    }
    __syncthreads();
}

__global__ void __launch_bounds__(NWAVES * 64, 2) fwd(Args args) {
    extern __shared__ __attribute__((aligned(16))) unsigned char lds[];
    Frame F;
    F.lds = (LAS unsigned char*)lds;
    F.tid = threadIdx.x; F.lane = F.tid & 63; F.wave = __builtin_amdgcn_readfirstlane(F.tid >> 6);
    F.G = gridDim.x; { const int bx = blockIdx.x; F.vcu = (F.G % 8 == 0) ? (bx % 8) * (F.G / 8) + bx / 8 : bx; }
    unsigned char* ws = args.ws;
    const int lo = args.ph_lo, hi = args.ph_hi;
    for (int u = F.tid; u < (LDS_BYTES - RING_BYTES) / 4; u += NWAVES * 64) ((LAS unsigned*)(F.lds + RING_BYTES))[u] = 0u;
    __syncthreads();
    if (args.coop == 2) cg::this_grid().sync();
    XcdBarrier bar = xcd_barrier_post((unsigned*)(ws + WS_BAR), (volatile LAS unsigned*)(F.lds + MISC_OFF) + 8);
#define IN(k) (lo <= (k) && (k) < hi)
#define SEAM(k) do { if (IN(k) && IN((k) + 1)) { xcd_barrier(bar); } } while (0)
    if (IN(0)) { for (int rep = 0; rep < REP0; ++rep) p0_prologue(F, args); } SEAM(0);
    if (IN(1)) for (int rep = 0; rep < REP1; ++rep) {
        pg8::Gemm g{(const bf16*)(ws + WS_XN), (const bf16*)(ws + WS_WQKV), M, NPROJ, D}; pg8::StaticOrder S; S.init(M, NPROJ, F.G, (int)blockIdx.x);
        pg8::EpiBf16Plain E{(bf16*)(ws + WS_PROJ), NPROJ};
        pg8::gemm_phase<pg8::EpiBf16Plain, pg8::StaticOrder, PG8_ALIGN, PG8_SP2>(F.lds + RING_OFF, g, S, E);
    } SEAM(1);
    if (IN(2)) {
        const float lam = lam_of(args.in[3], args.in[4], args.in[5], args.in[6]);
        const bf16* proj = (const bf16*)(ws + WS_PROJ); bf16* mixo = (bf16*)(ws + WS_MIX);
        for (int pr_ = F.vcu; pr_ < BATCH * 4 * 4 * REP2D; pr_ += F.G) { const int pr = pr_ & (BATCH * 4 * 4 - 1), bh = pr >> 2, s = pr & 3;
            for (int k = 0; k < 2; ++k) mixer::diff_unit(F.lds, proj, mixo, bh >> 2, bh & 3, k ? s : 7 - s, lam, args.in[7]); }
        for (int u_ = F.vcu; u_ < BATCH * 8 * 8 * REP2S; u_ += F.G) { const int u = u_ & (BATCH * 8 * 8 - 1), bh = u >> 3, qb = (u + (u >> 8) * 3) & 7;
            mixer::sb_unit(F.lds, proj, mixo, bh >> 3, bh & 7, qb, args.in[8]); }
    }
    SEAM(2);
    if (IN(3) && REP3 > 1) {
        pg8::Gemm g{(const bf16*)(ws + WS_MIX), (const bf16*)(ws + WS_WO), M, D, D}; pg8::StaticOrder S; S.init(M, D, F.G, (int)blockIdx.x);
        pg8::EpiResidB<true> E{args.in[0], (bf16*)(ws + WS_PROJ), (float*)(ws + 512 * 1024), D};
        pg8::gemm_phase<pg8::EpiResidB<true>, pg8::StaticOrder, PG8_ALIGN, PG8_SP2>(F.lds + RING_OFF, g, S, E);
    }
    if (IN(3)) {
        pg8::Gemm g{(const bf16*)(ws + WS_MIX), (const bf16*)(ws + WS_WO), M, D, D}; pg8::StaticOrder S; S.init(M, D, F.G, (int)blockIdx.x);
        pg8::EpiResidB<true> E{args.in[0], (bf16*)(ws + WS_XN), (float*)(ws + WS_SS1), D};
        pg8::gemm_phase<pg8::EpiResidB<true>, pg8::StaticOrder, PG8_ALIGN, PG8_SP2>(F.lds + RING_OFF, g, S, E);
    } SEAM(3);
    if (IN(4)) for (int rep = 0; rep < REP4; ++rep) {
        pg8::Gemm g{(const bf16*)(ws + WS_XN), (const bf16*)(ws + WS_W1), M, FF, D}; pg8::StaticOrder S; S.init(M, FF, F.G, (int)blockIdx.x);
        pg8::EpiSqRelu E{(bf16*)(ws + WS_U), FF, (const float*)(ws + WS_SS1)};
        pg8::gemm_phase<pg8::EpiSqRelu, pg8::StaticOrder, PG8_ALIGN, PG8_SP2>(F.lds + RING_OFF, g, S, E);
    } SEAM(4);
    if (IN(5) && REP5 > 1) {
        pg8::Gemm g{(const bf16*)(ws + WS_U), (const bf16*)(ws + WS_W2), M, D, FF}; pg8::StaticOrder S; S.init(M, D, F.G, (int)blockIdx.x);
        pg8::EpiResidB<false> E{(const bf16*)(ws + WS_XN), (bf16*)(ws + 352 * MiB), (float*)(ws + 512 * 1024), D};
        pg8::gemm_phase<pg8::EpiResidB<false>, pg8::StaticOrder, PG8_ALIGN, PG8_SP2>(F.lds + RING_OFF, g, S, E);
    }
    if (IN(5)) {
        pg8::Gemm g{(const bf16*)(ws + WS_U), (const bf16*)(ws + WS_W2), M, D, FF}; pg8::StaticOrder S; S.init(M, D, F.G, (int)blockIdx.x);
        pg8::EpiResidB<false> E{(const bf16*)(ws + WS_XN), (bf16*)(ws + WS_XN), (float*)(ws + WS_SS2), D};
        pg8::gemm_phase<pg8::EpiResidB<false>, pg8::StaticOrder, PG8_ALIGN, PG8_SP2>(F.lds + RING_OFF, g, S, E);
    } SEAM(5);
    if (IN(6) && REP6 > 1) { p6_final(F, args, (float*)(ws + 352 * MiB)); }
    if (IN(6)) { p6_final(F, args, args.out); }
#undef IN
#undef SEAM
}

extern "C" void kernel_launch(void* const* d_in, const int* in_sizes, int n_in, void* d_out, int out_size, void* d_ws, size_t ws_size, hipStream_t stream) {
    static int grid = 0;
    if (grid == 0) {
        if (n_in != 14 || in_sizes[0] != M * D || out_size != M * D || ws_size < WS_END) { fprintf(stderr, "kernel_launch: unexpected shapes (n_in %d, in0 %d, out %d, ws %zu)\n", n_in, n_in > 0 ? in_sizes[0] : -1, out_size, ws_size); grid = -1; return; }
        int dev = 0, cus = 0;
        if (hipGetDevice(&dev) != hipSuccess || hipDeviceGetAttribute(&cus, hipDeviceAttributeMultiprocessorCount, dev) != hipSuccess) { grid = -1; return; }
        if (hipFuncSetAttribute((const void*)fwd, hipFuncAttributeMaxDynamicSharedMemorySize, LDS_BYTES) != hipSuccess) { fprintf(stderr, "kernel_launch: hipFuncSetAttribute failed\n"); grid = -1; return; }
        grid = cus;
    }
    if (grid < 0) return;
    (void)hipMemsetAsync((char*)d_ws + WS_CTL, 0, CTL_ZERO_BYTES, stream);
    Args a{};
    for (int i = 0; i < 14; ++i) a.in[i] = (const float*)d_in[i];
    a.out = (float*)d_out; a.ws = (unsigned char*)d_ws; a.coop = 0; a.pad = 0;
    unsigned char* ws = (unsigned char*)d_ws;
    a.ph_lo = 0; a.ph_hi = 7; a.coop = 1;
    void* kargs[] = {&a};
    hipError_t e = hipLaunchCooperativeKernel((const void*)fwd, dim3(grid), dim3(NWAVES * 64), kargs, LDS_BYTES, stream);
    if (e != hipSuccess) fprintf(stderr, "kernel_launch: cooperative launch failed: %s (grid %d)\n", hipGetErrorString(e), grid);
}
```

```cpp
#include <hip/hip_runtime.h>
#include <hip/hip_cooperative_groups.h>
#include <cstdio>
#include <cstdint>
namespace cg = cooperative_groups;
namespace pg8 {
#define PG8_LAS __attribute__((address_space(3)))
typedef unsigned short bf16_t;
typedef short bf16x8 __attribute__((ext_vector_type(8)));
typedef float f32x4 __attribute__((ext_vector_type(4)));
typedef unsigned u32x4 __attribute__((ext_vector_type(4)));
constexpr int BM = 256, BK = 64, HALF = 128, HTB = HALF * BK * 2  , STAGE_BYTES = 8 * HTB, NXCD = 8, WGM = 8;

__host__ __device__ __forceinline__ int lds_byte(int r, int c) { const int st = (r >> 4) * 2 + (c >> 5), rr = r & 15, cc = c & 31, ob = rr * 64 + cc * 2; return st * 1024 + (ob ^ (((ob >> 9) & 1) << 5)); }
__host__ __device__ __forceinline__ void stage_rc(int b, int& R, int& C) { const int st = b / 1024, sb = b % 1024, swz = sb ^ (((sb >> 9) & 1) << 5); R = (st >> 1) * 16 + swz / 64; C = (st & 1) * 32 + (swz % 64) / 2; }
__host__ __device__ __forceinline__ int perm32(int rho) { const int n = rho >> 4, i = rho & 15; return 8 * (i >> 2) + 4 * n + (i & 3); }

struct Unit { int pm, pn; };
struct Gemm { const bf16_t* A; const bf16_t* Bt; int M, N, K; };

struct StaticOrder {
    int nM, nN, nwg, G, c;
    __host__ __device__ void init(int M, int N, int G_, int c_) { nM = M / BM; nN = N / BM; nwg = nM * nN; G = G_; c = c_; }
    __host__ __device__ bool next(int i, Unit& u) const {
        const long L = (long)i * G + c; if (L >= nwg) return false;
        int wgid = (int)L; { const int q = nwg / NXCD, r = nwg % NXCD, xcd = wgid % NXCD, off = wgid / NXCD; wgid = (xcd < r ? xcd * (q + 1) : r * (q + 1) + (xcd - r) * q) + off; }
        const int nig = WGM * nN, gid = wgid / nig, fm = gid * WGM, gsz = (nM - fm) < WGM ? (nM - fm) : WGM;
        u.pm = fm + ((wgid % nig) % gsz); u.pn = (wgid % nig) / gsz; return true;
    }
    __device__ __forceinline__ void a_ready(const Unit&) const {}
    __device__ __forceinline__ void done(const Unit&) const {}
};

__device__ __forceinline__ unsigned cvt_pk_bf16(float lo, float hi) { unsigned r; asm volatile("v_cvt_pk_bf16_f32 %0, %1, %2" : "=v"(r) : "v"(lo), "v"(hi)); return r; }
typedef unsigned u32x2 __attribute__((ext_vector_type(2)));
struct EpiBf16Plain {
    static constexpr bool PERM = true, AFTER_DRAIN = false;
    bf16_t* O; int ldc; float qscale;
    __device__ __forceinline__ void operator()(const f32x4 (&acc)[2][2][4][2], const Unit& u, int wr, int wc, int fr, int fq) const {
        const int row0 = u.pm * BM + wr * 64 + fr; const int col0 = u.pn * BM + wc * 32 + 8 * fq;
        const float sc = (u.pn < 2 || u.pn == 6 || u.pn == 7) ? qscale : 1.f;
#pragma unroll
        for (int ai = 0; ai < 2; ++ai)
#pragma unroll
            for (int m = 0; m < 4; ++m) { bf16_t* rowp = O + (size_t)(row0 + ai * HALF + m * 16) * ldc + col0;
#pragma unroll
                for (int bj = 0; bj < 2; ++bj) { const f32x4 v0 = acc[ai][bj][m][0] * sc, v1 = acc[ai][bj][m][1] * sc;
                    u32x4 w; w.x = cvt_pk_bf16(v0[0], v0[1]); w.y = cvt_pk_bf16(v0[2], v0[3]); w.z = cvt_pk_bf16(v1[0], v1[1]); w.w = cvt_pk_bf16(v1[2], v1[3]);
                    *(u32x4*)(rowp + bj * HALF) = w; } }
    }
};
struct EpiSqRelu {
    static constexpr bool PERM = true, AFTER_DRAIN = false;
    bf16_t* O; int ldc; const float* ss;
    __device__ __forceinline__ void operator()(const f32x4 (&acc)[2][2][4][2], const Unit& u, int wr, int wc, int fr, int fq) const {
        const int row0 = u.pm * BM + wr * 64 + fr; const int col0 = u.pn * BM + wc * 32 + 8 * fq;
#pragma unroll
        for (int ai = 0; ai < 2; ++ai)
#pragma unroll
            for (int m = 0; m < 4; ++m) { const int row = row0 + ai * HALF + m * 16; bf16_t* rowp = O + (size_t)row * ldc + col0;
                const float sv = __hip_atomic_load(ss + row, __ATOMIC_RELAXED, __HIP_MEMORY_SCOPE_AGENT);
                const float inv = rsqrtf(sv * (1.0f / 1024.0f) + 1e-6f), inv2 = inv * inv;
#pragma unroll
                for (int bj = 0; bj < 2; ++bj) { f32x4 v0 = acc[ai][bj][m][0], v1 = acc[ai][bj][m][1];
#pragma unroll
                    for (int e = 0; e < 4; ++e) { const float a = fmaxf(v0[e], 0.f), b = fmaxf(v1[e], 0.f); v0[e] = a * a * inv2; v1[e] = b * b * inv2; }
                    u32x4 w; w.x = cvt_pk_bf16(v0[0], v0[1]); w.y = cvt_pk_bf16(v0[2], v0[3]); w.z = cvt_pk_bf16(v1[0], v1[1]); w.w = cvt_pk_bf16(v1[2], v1[3]);
                    *(u32x4*)(rowp + bj * HALF) = w; } }
    }
};
struct EpiResid {
    static constexpr bool PERM = false, AFTER_DRAIN = false;
    const float* base; float* out; bf16_t* ob; float* ss; int ldc;
    __device__ __forceinline__ void operator()(const f32x4 (&acc)[2][2][4][2], const Unit& u, int wr, int wc, int fr, int fq) const {
        const int col0 = u.pn * BM + wc * 32 + 4 * fq;
#pragma unroll
        for (int ai = 0; ai < 2; ++ai)
#pragma unroll
            for (int m = 0; m < 4; ++m) { const int r = u.pm * BM + ai * HALF + wr * 64 + m * 16 + fr; const size_t off = (size_t)r * ldc + col0; float s = 0.f;
#pragma unroll
                for (int bj = 0; bj < 2; ++bj)
#pragma unroll
                    for (int n = 0; n < 2; ++n) { const f32x4 bs = *(const f32x4*)(base + off + bj * HALF + n * 16); const f32x4 o = bs + acc[ai][bj][m][n];
                        *(f32x4*)(out + off + bj * HALF + n * 16) = o; s += (o[0] * o[0] + o[1] * o[1]) + (o[2] * o[2] + o[3] * o[3]);
                        if (ob) { u32x2 w; w.x = cvt_pk_bf16(o[0], o[1]); w.y = cvt_pk_bf16(o[2], o[3]); *(u32x2*)(ob + off + bj * HALF + n * 16) = w; } }
                s += __shfl_xor(s, 16); s += __shfl_xor(s, 32);
                if (fq == 0) (void)__hip_atomic_fetch_add(ss + r, s, __ATOMIC_RELAXED, __HIP_MEMORY_SCOPE_AGENT); }
    }
};
template <bool BASE_F32> struct EpiResidB {
    static constexpr bool PERM = true, AFTER_DRAIN = false;
    const void* base; bf16_t* out; float* ss; int ldc;
    __device__ __forceinline__ void operator()(const f32x4 (&acc)[2][2][4][2], const Unit& u, int wr, int wc, int fr, int fq) const {
        const int row0 = u.pm * BM + wr * 64 + fr; const int col0 = u.pn * BM + wc * 32 + 8 * fq;
#pragma unroll
        for (int ai = 0; ai < 2; ++ai)
#pragma unroll
            for (int m = 0; m < 4; ++m) { const int row = row0 + ai * HALF + m * 16; const size_t off = (size_t)row * ldc + col0; float s = 0.f;
#pragma unroll
                for (int bj = 0; bj < 2; ++bj) { f32x4 v0 = acc[ai][bj][m][0], v1 = acc[ai][bj][m][1];
                    if (BASE_F32) { const float* bp = (const float*)base + off + bj * HALF; v0 += *(const f32x4*)bp; v1 += *(const f32x4*)(bp + 4); }
                    else { const u32x4 bw = *(const u32x4*)((const bf16_t*)base + off + bj * HALF);
                        v0[0] += __builtin_bit_cast(float, bw.x << 16); v0[1] += __builtin_bit_cast(float, bw.x & 0xffff0000u); v0[2] += __builtin_bit_cast(float, bw.y << 16); v0[3] += __builtin_bit_cast(float, bw.y & 0xffff0000u);
                        v1[0] += __builtin_bit_cast(float, bw.z << 16); v1[1] += __builtin_bit_cast(float, bw.z & 0xffff0000u); v1[2] += __builtin_bit_cast(float, bw.w << 16); v1[3] += __builtin_bit_cast(float, bw.w & 0xffff0000u); }
                    s += ((v0[0] * v0[0] + v0[1] * v0[1]) + (v0[2] * v0[2] + v0[3] * v0[3])) + ((v1[0] * v1[0] + v1[1] * v1[1]) + (v1[2] * v1[2] + v1[3] * v1[3]));
                    u32x4 w; w.x = cvt_pk_bf16(v0[0], v0[1]); w.y = cvt_pk_bf16(v0[2], v0[3]); w.z = cvt_pk_bf16(v1[0], v1[1]); w.w = cvt_pk_bf16(v1[2], v1[3]);
                    *(u32x4*)(out + off + bj * HALF) = w; }
                s += __shfl_xor(s, 16); s += __shfl_xor(s, 32);
                if (fq == 0) (void)__hip_atomic_fetch_add(ss + row, s, __ATOMIC_RELAXED, __HIP_MEMORY_SCOPE_AGENT); }
    }
};

template <class Epi, class Sched, bool ALIGN_EPI = false, bool SP2 = false>
__device__ __forceinline__ void gemm_phase(PG8_LAS unsigned char* lds, const Gemm g, const Sched& S, const Epi& E) {
    const int tid = threadIdx.x, wid = __builtin_amdgcn_readfirstlane(tid >> 6), lane = tid & 63, wr = wid >> 2, wc = wid & 3, fr = lane & 15, fq = lane >> 4;
    const int K = g.K, nt = K / BK;
    unsigned voffA[2], voffB[2];
#pragma unroll
    for (int i = 0; i < 2; ++i) { int R, C; stage_rc(tid * 16 + i * 8192, R, C); const int Rb = Epi::PERM ? ((R & ~31) + perm32(R & 31)) : R;
        voffA[i] = (unsigned)(R * K + C) * 2u; voffB[i] = (unsigned)(Rb * K + C) * 2u; }
    const size_t kstep = (size_t)(BK * 2);
    const size_t hstep = (size_t)HALF * K * 2;
    const size_t tstep = 2 * hstep;
    const unsigned ldsw = (unsigned)wid * 1024u;
    const int aoff = lds_byte(wr * 64 + fr, fq * 8), boff = lds_byte(wc * 32 + fr, fq * 8);
#define PG8_SA(b, h) (((b) * 2 + (h)) * HTB)
#define PG8_SB(b, h) ((4 + (b) * 2 + (h)) * HTB)
#define PG8_STAGE(bufoff, gbase, voff) do { _Pragma("unroll") for (int _i = 0; _i < 2; ++_i) \
        __builtin_amdgcn_global_load_lds((const unsigned*)((const char*)(gbase) + (voff)[_i]), (PG8_LAS unsigned*)(lds + (bufoff) + ldsw + _i * 8192), 16, 0, 0); } while (0)
#define PG8_LDA(dst, b, h) do { _Pragma("unroll") for (int m = 0; m < 4; ++m) _Pragma("unroll") for (int k = 0; k < 2; ++k) dst[m][k] = *(const PG8_LAS bf16x8*)(lds + PG8_SA(b, h) + aoff + m * 2048 + k * 1024); } while (0)
#define PG8_LDB(dst, b, h) do { _Pragma("unroll") for (int n = 0; n < 2; ++n) _Pragma("unroll") for (int k = 0; k < 2; ++k) dst[n][k] = *(const PG8_LAS bf16x8*)(lds + PG8_SB(b, h) + boff + n * 2048 + k * 1024); } while (0)
#define PG8_MMA(ai, bj, At, Bt) do { __builtin_amdgcn_s_setprio(1); _Pragma("unroll") for (int m = 0; m < 4; ++m) _Pragma("unroll") for (int n = 0; n < 2; ++n) _Pragma("unroll") for (int k = 0; k < 2; ++k) \
        acc[ai][bj][m][n] = __builtin_amdgcn_mfma_f32_16x16x32_bf16(Bt[n][k], At[m][k], acc[ai][bj][m][n], 0, 0, 0); __builtin_amdgcn_s_setprio(0); } while (0)
#define PG8_WAIT_V(n) asm volatile("s_waitcnt vmcnt(" #n ")" ::: "memory")
#define PG8_WAIT_L(n) asm volatile("s_waitcnt lgkmcnt(" #n ")" ::: "memory")
#define PG8_BAR __builtin_amdgcn_s_barrier()
#define PG8_SCHED __builtin_amdgcn_sched_barrier(0)
    Unit cur, nxt; int ui = 0;
    if (!S.next(0, cur)) return;
    f32x4 acc[2][2][4][2];
#pragma unroll
    for (int a = 0; a < 2; ++a)
#pragma unroll
        for (int b = 0; b < 2; ++b)
#pragma unroll
            for (int m = 0; m < 4; ++m)
#pragma unroll
                for (int n = 0; n < 2; ++n) acc[a][b][m][n] = (f32x4){0.f, 0.f, 0.f, 0.f};
    bf16x8 At[4][2], B0[2][2], B1[2][2];
    const char* cA = (const char*)g.A + (size_t)cur.pm * tstep; const char* cB = (const char*)g.Bt + (size_t)cur.pn * tstep;
    S.a_ready(cur);
    if constexpr (SP2) {
        PG8_STAGE(PG8_SB(0, 0), cB, voffB); PG8_STAGE(PG8_SB(0, 1), cB + hstep, voffB); PG8_STAGE(PG8_SA(0, 0), cA, voffA); PG8_STAGE(PG8_SA(0, 1), cA + hstep, voffA);
        if (wr == 1) PG8_BAR;
        PG8_WAIT_V(2); PG8_BAR;
        PG8_STAGE(PG8_SB(1, 0), cB + kstep, voffB); PG8_STAGE(PG8_SA(1, 0), cA + kstep, voffA); PG8_STAGE(PG8_SB(1, 1), cB + hstep + kstep, voffB);
        PG8_WAIT_V(6); PG8_BAR;
    } else {
        PG8_STAGE(PG8_SB(0, 0), cB, voffB); PG8_STAGE(PG8_SA(0, 0), cA, voffA); PG8_STAGE(PG8_SB(0, 1), cB + hstep, voffB); PG8_STAGE(PG8_SA(0, 1), cA + hstep, voffA);
        if (wr == 1) PG8_BAR;
        PG8_WAIT_V(4); PG8_BAR;
        PG8_STAGE(PG8_SB(1, 0), cB + kstep, voffB); PG8_STAGE(PG8_SA(1, 0), cA + kstep, voffA); PG8_STAGE(PG8_SB(1, 1), cB + hstep + kstep, voffB);
        PG8_WAIT_V(6); PG8_BAR;
    }
    for (;;) {
        const bool has_next = S.next(ui + 1, nxt);
        const char* nA = has_next ? (const char*)g.A + (size_t)nxt.pm * tstep : cA; const char* nB = has_next ? (const char*)g.Bt + (size_t)nxt.pn * tstep : cB;
        for (int t = 0; t < nt; t += 2) {
            const bool last = (t == nt - 2);
            const char* a1 = cA + (size_t)(t + 1) * kstep;
            const char* a2 = last ? nA : cA + (size_t)(t + 2) * kstep; const char* b2 = last ? nB : cB + (size_t)(t + 2) * kstep;
            const char* a3 = a2 + kstep; const char* b3 = b2 + kstep;
            if (last && has_next) S.a_ready(nxt);
            if constexpr (SP2) {
            PG8_LDB(B0, 0, 0); PG8_LDB(B1, 0, 1); PG8_SCHED; PG8_LDA(At, 0, 0); PG8_STAGE(PG8_SA(1, 1), a1 + hstep, voffA);
            PG8_WAIT_V(8); PG8_WAIT_L(0); PG8_BAR; PG8_MMA(0, 0, At, B0); PG8_MMA(0, 1, At, B1); PG8_BAR; PG8_SCHED;
            PG8_LDA(At, 0, 1); PG8_STAGE(PG8_SB(0, 0), b2, voffB); PG8_STAGE(PG8_SB(0, 1), b2 + hstep, voffB); PG8_STAGE(PG8_SA(0, 0), a2, voffA);
            PG8_WAIT_V(8); PG8_WAIT_L(0); PG8_BAR; PG8_MMA(1, 0, At, B0); PG8_MMA(1, 1, At, B1); PG8_BAR; PG8_SCHED;
            PG8_LDB(B0, 1, 0); PG8_LDB(B1, 1, 1); PG8_SCHED; PG8_LDA(At, 1, 0); PG8_STAGE(PG8_SA(0, 1), a2 + hstep, voffA);
            PG8_WAIT_V(8); PG8_WAIT_L(0); PG8_BAR; PG8_MMA(0, 0, At, B0); PG8_MMA(0, 1, At, B1); PG8_BAR; PG8_SCHED;
            PG8_LDA(At, 1, 1); PG8_STAGE(PG8_SB(1, 0), b3, voffB); PG8_STAGE(PG8_SB(1, 1), b3 + hstep, voffB); PG8_STAGE(PG8_SA(1, 0), a3, voffA);
            PG8_WAIT_V(8); PG8_WAIT_L(0); PG8_BAR; PG8_MMA(1, 0, At, B0); PG8_MMA(1, 1, At, B1); PG8_BAR; PG8_SCHED;
            } else {
            PG8_LDB(B0, 0, 0); PG8_SCHED; PG8_LDA(At, 0, 0); PG8_STAGE(PG8_SA(1, 1), a1 + hstep, voffA);
            PG8_WAIT_L(8); PG8_BAR; PG8_WAIT_L(0); PG8_MMA(0, 0, At, B0); PG8_BAR; PG8_SCHED;
            PG8_LDB(B1, 0, 1); PG8_STAGE(PG8_SB(0, 0), b2, voffB);
            PG8_BAR; PG8_WAIT_L(0); PG8_MMA(0, 1, At, B1); PG8_BAR;
            PG8_LDA(At, 0, 1); PG8_STAGE(PG8_SA(0, 0), a2, voffA);
            PG8_BAR; PG8_WAIT_L(0); PG8_MMA(1, 0, At, B0); PG8_BAR; PG8_SCHED;
            PG8_STAGE(PG8_SB(0, 1), b2 + hstep, voffB);
            PG8_WAIT_V(6); PG8_BAR; PG8_MMA(1, 1, At, B1); PG8_BAR;
            PG8_LDB(B0, 1, 0); PG8_SCHED; PG8_LDA(At, 1, 0); PG8_STAGE(PG8_SA(0, 1), a2 + hstep, voffA);
            PG8_WAIT_L(8); PG8_BAR; PG8_WAIT_L(0); PG8_MMA(0, 0, At, B0); PG8_BAR; PG8_SCHED;
            PG8_LDB(B1, 1, 1); PG8_STAGE(PG8_SB(1, 0), b3, voffB);
            PG8_BAR; PG8_WAIT_L(0); PG8_MMA(0, 1, At, B1); PG8_BAR;
            PG8_LDA(At, 1, 1); PG8_STAGE(PG8_SA(1, 0), a3, voffA);
            PG8_BAR; PG8_WAIT_L(0); PG8_MMA(1, 0, At, B0); PG8_BAR; PG8_SCHED;
            PG8_STAGE(PG8_SB(1, 1), b3 + hstep, voffB);
            PG8_WAIT_V(6); PG8_BAR; PG8_MMA(1, 1, At, B1); PG8_BAR;
            }
        }
        if constexpr (ALIGN_EPI) { if (wr == 0) PG8_BAR; }
        if constexpr (!Epi::AFTER_DRAIN) { E(acc, cur, wr, wc, fr, fq); S.done(cur); }
        if (!has_next) break;
#pragma unroll
        for (int a = 0; a < 2; ++a)
#pragma unroll
            for (int b = 0; b < 2; ++b)
#pragma unroll
                for (int m = 0; m < 4; ++m)
#pragma unroll
                    for (int n = 0; n < 2; ++n) acc[a][b][m][n] = (f32x4){0.f, 0.f, 0.f, 0.f};
        cur = nxt; cA = nA; cB = nB; ++ui;
        if constexpr (ALIGN_EPI) { if (wr == 1) PG8_BAR; }
    }
    PG8_WAIT_V(0);
    if constexpr (!ALIGN_EPI) { if (wr == 0) PG8_BAR; }
    PG8_BAR;
    if constexpr (Epi::AFTER_DRAIN) { E.fused(acc, cur, wr, wc, fr, fq, lds, wid, lane); S.done(cur); }
#undef PG8_SA
#undef PG8_SB
#undef PG8_STAGE
#undef PG8_LDA
#undef PG8_LDB
#undef PG8_MMA
#undef PG8_WAIT_V
#undef PG8_WAIT_L
#undef PG8_BAR
#undef PG8_SCHED
}
}
#ifndef PG8_SP2
#define PG8_SP2 true
#endif
#ifndef PG8_ALIGN
#define PG8_ALIGN true
#endif
constexpr int NWAVES = 8;
constexpr int BATCH = 16, SEQ = 2048, D = 1024, FF = 4096, NPROJ = 3072;
constexpr int M = BATCH * SEQ;
constexpr float EPS = 1e-6f;
constexpr int C_DQ = 0, C_DK = 512, C_DV = 1024, C_SQ = 1536, C_SK = 2048, C_SV = 2560;
constexpr size_t MiB = 1u << 20;
constexpr size_t WS_CTL = 0, CTL_ZERO_BYTES = 1 * MiB;
constexpr size_t WS_SS1 = 0, WS_SS2 = 256 * 1024;
constexpr size_t WS_WQKV = 2 * MiB, WS_WO = 8 * MiB, WS_W1 = 10 * MiB, WS_W2 = 18 * MiB;
constexpr size_t WS_XN = 32 * MiB;
constexpr size_t WS_PROJ = 96 * MiB;
constexpr size_t WS_MIX = 288 * MiB;
constexpr size_t WS_U = 96 * MiB;
constexpr size_t WS_END = 352 * MiB;
constexpr int RING_OFF = 0, RING_BYTES = 131072;
constexpr int LDS_BYTES = 147456;

#define GAS __attribute__((address_space(1)))
#define LAS __attribute__((address_space(3)))
typedef unsigned short bf16;
typedef unsigned v4u __attribute__((ext_vector_type(4)));
typedef float f32x4 __attribute__((ext_vector_type(4)));
#define LDS_WAIT() asm volatile("s_waitcnt lgkmcnt(0)" ::: "memory")
__device__ __forceinline__ unsigned f2bf(float f) { unsigned u = __builtin_bit_cast(unsigned, f); return (u + 0x7fffu + ((u >> 16) & 1u)) >> 16; }
__device__ __forceinline__ unsigned pk2(float lo, float hi) { return f2bf(lo) | (f2bf(hi) << 16); }
__device__ __forceinline__ float bflo(unsigned w) { return __builtin_bit_cast(float, w << 16); }
__device__ __forceinline__ float bfhi(unsigned w) { return __builtin_bit_cast(float, w & 0xffff0000u); }

struct Frame {
    LAS unsigned char* lds;
    int tid, lane, wave, vcu, G;
};
__device__ __forceinline__ float wave_sum(float v) {
#pragma unroll
    for (int o = 1; o < 64; o <<= 1) v += __shfl_xor(v, o);
    return v;
}
__device__ __forceinline__ void p0_transpose_item(const float* W, int K, int N, bf16* WT, const float* ks, LAS float* scr, int item, int lane) {
    const int nblk = N / 32, kb = item / nblk, nb = item % nblk, k0 = 64 * kb, n0 = 32 * nb;
#pragma unroll 8
    for (int i = 0; i < 32; ++i) { const int kk = 2 * i + (lane >> 5); float v = W[(size_t)(k0 + kk) * N + n0 + (lane & 31)]; if (ks) v *= ks[k0 + kk]; scr[kk * 33 + (lane & 31)] = v; }
    LDS_WAIT(); asm volatile("" ::: "memory");
    const int c = lane & 7;
#pragma unroll
    for (int j = 0; j < 4; ++j) { const int n = (lane >> 3) + 8 * j; const LAS float* s = scr + (8 * c) * 33 + n;
        v4u o; o.x = pk2(s[0 * 33], s[1 * 33]); o.y = pk2(s[2 * 33], s[3 * 33]); o.z = pk2(s[4 * 33], s[5 * 33]); o.w = pk2(s[6 * 33], s[7 * 33]);
        *(GAS v4u*)(WT + (size_t)(n0 + n) * K + k0 + 8 * c) = o; }
    LDS_WAIT(); asm volatile("" ::: "memory");
}
template <int NR> __device__ __forceinline__ void rms_rows_to_bf16(int lane, const float* x, size_t m0, size_t rs, const float* g, bf16* o) {
    const GAS f32x4* gr = (const GAS f32x4*)g + lane;
    f32x4 v[NR][4];
#pragma unroll
    for (int i = 0; i < NR; ++i) { const GAS f32x4* xr = (const GAS f32x4*)(x + (m0 + i * rs) * D) + lane;
#pragma unroll
        for (int j = 0; j < 4; ++j) v[i][j] = __builtin_nontemporal_load(xr + 64 * j); }
    f32x4 gg[4];
#pragma unroll
    for (int j = 0; j < 4; ++j) gg[j] = gr[64 * j];
#pragma unroll
    for (int i = 0; i < NR; ++i) { float s = 0.f;
#pragma unroll
        for (int j = 0; j < 4; ++j) s += (v[i][j].x * v[i][j].x + v[i][j].y * v[i][j].y) + (v[i][j].z * v[i][j].z + v[i][j].w * v[i][j].w);
        const float inv = rsqrtf(wave_sum(s) * (1.f / D) + EPS);
        GAS unsigned long long* o8 = (GAS unsigned long long*)(o + (m0 + i * rs) * D) + lane;
#pragma unroll
        for (int j = 0; j < 4; ++j) o8[64 * j] = (unsigned long long)pk2(v[i][j].x * inv * gg[j].x, v[i][j].y * inv * gg[j].y) | ((unsigned long long)pk2(v[i][j].z * inv * gg[j].z, v[i][j].w * inv * gg[j].w) << 32); }
}
struct Args { const float* in[14]; float* out; unsigned char* ws; int ph_lo, ph_hi, coop, pad; };

__device__ __forceinline__ void p0_prologue(Frame& F, const Args& a) {
    LAS float* scr = (LAS float*)(F.lds + RING_OFF + F.wave * 16384);
    const int gw = F.vcu * NWAVES + F.wave, NGW = F.G * NWAVES;
    unsigned char* ws = a.ws;
    constexpr int I_IN = (D / 64) * (NPROJ / 32), I_O = (D / 64) * (D / 32), I_1 = (D / 64) * (FF / 32), I_2 = (FF / 64) * (D / 32);
    constexpr int NITEMS = I_IN + I_O + I_1 + I_2;
    for (int ph = 0; ph < 2; ++ph) {
    if (((ph ^ F.wave) & 1) == 0) {
    for (int it = gw; it < NITEMS; it += NGW) {
        int r = it;
        if (r < I_IN) { p0_transpose_item(a.in[2], D, NPROJ, (bf16*)(ws + WS_WQKV), nullptr, scr, r, F.lane); continue; } r -= I_IN;
        if (r < I_O) { p0_transpose_item(a.in[9], D, D, (bf16*)(ws + WS_WO), nullptr, scr, r, F.lane); continue; } r -= I_O;
        if (r < I_1) { p0_transpose_item(a.in[11], D, FF, (bf16*)(ws + WS_W1), a.in[10], scr, r, F.lane); continue; } r -= I_1;
        p0_transpose_item(a.in[12], FF, D, (bf16*)(ws + WS_W2), nullptr, scr, r, F.lane);
    }
    } else {
    int m = gw;
    for (; m + 3 * NGW < M; m += 4 * NGW) rms_rows_to_bf16<4>(F.lane, a.in[0], (size_t)m, (size_t)NGW, a.in[1], (bf16*)(ws + WS_XN));
    for (; m < M; m += NGW) rms_rows_to_bf16<1>(F.lane, a.in[0], (size_t)m, (size_t)NGW, a.in[1], (bf16*)(ws + WS_XN));
    }
    }
}
template <int NR> __device__ __forceinline__ void p6_rows(int lane, const bf16* hb, const float* ss2, const f32x4 (&gg)[4], float* dst, size_t m0, size_t rs) {
    v4u w[NR][2]; float sv[NR];
#pragma unroll
    for (int i = 0; i < NR; ++i) { const size_t mm = m0 + i * rs; sv[i] = __hip_atomic_load(ss2 + mm, __ATOMIC_RELAXED, __HIP_MEMORY_SCOPE_AGENT);
#pragma unroll
        for (int j = 0; j < 2; ++j) w[i][j] = __builtin_nontemporal_load((const GAS v4u*)(hb + mm * D + 512 * j + 8 * lane)); }
#pragma unroll
    for (int i = 0; i < NR; ++i) { const size_t mm = m0 + i * rs; const float inv = rsqrtf(sv[i] * (1.f / D) + EPS);
#pragma unroll
        for (int j = 0; j < 2; ++j) { const v4u x = w[i][j];
            f32x4 o0 = {bflo(x.x), bfhi(x.x), bflo(x.y), bfhi(x.y)}, o1 = {bflo(x.z), bfhi(x.z), bflo(x.w), bfhi(x.w)};
            o0 = o0 * inv * gg[2 * j]; o1 = o1 * inv * gg[2 * j + 1];
            GAS f32x4* op = (GAS f32x4*)(dst + mm * D + 512 * j + 8 * lane); __builtin_nontemporal_store(o0, op); __builtin_nontemporal_store(o1, op + 1); } }
}
__device__ __forceinline__ void p6_final(Frame& F, const Args& a, float* dst) {
    const int gw = F.vcu * NWAVES + F.wave, NGW = F.G * NWAVES;
    const float* ss2 = (const float*)(a.ws + WS_SS2); const bf16* hb = (const bf16*)(a.ws + WS_XN);
    f32x4 gg[4];
#pragma unroll
    for (int j = 0; j < 2; ++j) { gg[2 * j] = *(const GAS f32x4*)(a.in[13] + 512 * j + 8 * F.lane); gg[2 * j + 1] = *(const GAS f32x4*)(a.in[13] + 512 * j + 8 * F.lane + 4); }
    int m = gw;
    for (; m + 3 * NGW < M; m += 4 * NGW) p6_rows<4>(F.lane, hb, ss2, gg, dst, (size_t)m, (size_t)NGW);
    for (; m < M; m += NGW) p6_rows<1>(F.lane, hb, ss2, gg, dst, (size_t)m, (size_t)NGW);
}
typedef unsigned u32x4g __attribute__((ext_vector_type(4)));
__device__ __forceinline__ float lam_of(const float* lq1, const float* lk1, const float* lq2, const float* lk2) {
    float s1 = 0.f, s2 = 0.f;
    for (int i = 0; i < 64; ++i) { s1 += lq1[i] * lk1[i]; s2 += lq2[i] * lk2[i]; }
    return __expf(s1) - __expf(s2) + 0.2f;
}
namespace mixer {
typedef short bf16x8 __attribute__((ext_vector_type(8)));
typedef short s16x4 __attribute__((ext_vector_type(4)));
typedef short v4i16_t __attribute__((ext_vector_type(4)));
typedef float f32x16 __attribute__((ext_vector_type(16)));
typedef unsigned u32x4 __attribute__((ext_vector_type(4)));
typedef unsigned u32x2 __attribute__((ext_vector_type(2)));
typedef float f32x2_t __attribute__((ext_vector_type(2))); typedef __bf16 bf16x2_t __attribute__((ext_vector_type(2)));
constexpr int KSTR = 144, KBUF = 64 * KSTR;
constexpr int VSTRD = 320, VBUFD = 64 * VSTRD;
constexpr int VSTRS = 192, VBUFS = 64 * VSTRS;
constexpr int OFF_K = 0, OFF_V = 3 * KBUF, OFF_CNT = OFF_V + 3 * VBUFD;
static_assert(OFF_CNT + 128 <= RING_BYTES, "mixer LDS map");
constexpr float LOG2E = 1.4426950408889634f;
constexpr float QSCALE = 0.125f * LOG2E;
__device__ __forceinline__ s16x4 vtr(const LAS unsigned char* p) { return __builtin_bit_cast(s16x4, __builtin_amdgcn_ds_read_tr16_b64_v4i16((LAS v4i16_t*)p)); }
__device__ __forceinline__ unsigned cvtpk(float lo, float hi) { f32x2_t v = {lo, hi}; bf16x2_t b = __builtin_convertvector(v, bf16x2_t); return __builtin_bit_cast(unsigned, b); }
__device__ __forceinline__ float hmax(float v) { const unsigned b = __builtin_bit_cast(unsigned, v); auto rr = __builtin_amdgcn_permlane32_swap(b, b, false, false); return fmaxf(__builtin_bit_cast(float, (unsigned)rr[0]), __builtin_bit_cast(float, (unsigned)rr[1])); }
__device__ __forceinline__ float hsum(float v) { const unsigned b = __builtin_bit_cast(unsigned, v); auto rr = __builtin_amdgcn_permlane32_swap(b, b, false, false); return __builtin_bit_cast(float, (unsigned)rr[0]) + __builtin_bit_cast(float, (unsigned)rr[1]); }
#define CROW(r) (((r) & 3) + 8 * ((r) >> 2))
__device__ __forceinline__ void qk_tile(f32x16& p0, f32x16& p1, const LAS unsigned char* Kt, const bf16x8 (&qr)[4], int r32, int hi) {
    const LAS unsigned char* kb = Kt + r32 * KSTR + hi * 16;
#pragma unroll
    for (int d0 = 0; d0 < 4; ++d0) {
        const bf16x8 a0 = *(const LAS bf16x8*)(kb + d0 * 32), a1 = *(const LAS bf16x8*)(kb + 32 * KSTR + d0 * 32);
        p0 = __builtin_amdgcn_mfma_f32_32x32x16_bf16(a0, qr[d0], p0, 0, 0, 0); p1 = __builtin_amdgcn_mfma_f32_32x32x16_bf16(a1, qr[d0], p1, 0, 0, 0); }
}
__device__ __forceinline__ void pack_p(u32x4 (&pw)[4], const f32x16& p0, const f32x16& p1) {
#pragma unroll
    for (int e = 0; e < 4; ++e) { pw[0][e] = cvtpk(p0[2 * e], p0[2 * e + 1]); pw[1][e] = cvtpk(p0[8 + 2 * e], p0[9 + 2 * e]); pw[2][e] = cvtpk(p1[2 * e], p1[2 * e + 1]); pw[3][e] = cvtpk(p1[8 + 2 * e], p1[9 + 2 * e]); }
}
template <int NB, int VSTR> __device__ __forceinline__ void pv_packed(f32x16 (&o)[NB], const LAS unsigned char* vb, const u32x4 (&pw)[4]) {
#pragma unroll
    for (int ks = 0; ks < 4; ++ks)
#pragma unroll
        for (int nb = 0; nb < NB; ++nb) {
            const s16x4 lo = vtr(vb + (ks * 16) * VSTR + nb * 64), hh = vtr(vb + (ks * 16 + 8) * VSTR + nb * 64);
            const bf16x8 vf = {lo[0], lo[1], lo[2], lo[3], hh[0], hh[1], hh[2], hh[3]};
            o[nb] = __builtin_amdgcn_mfma_f32_32x32x16_bf16(vf, __builtin_bit_cast(bf16x8, pw[ks]), o[nb], 0, 0, 0); }
}
__device__ __forceinline__ void diff_unit(LAS unsigned char* lds, const bf16* proj, bf16* mixo, int b, int h, int qb, float lam, const float* g) {
    const int tid = threadIdx.x, lane = tid & 63, r32 = lane & 31, hi = lane >> 5, wid = __builtin_amdgcn_readfirstlane(tid >> 6);
    const size_t rowb = (size_t)b * SEQ; const int q0 = qb * 256, qw0 = q0 + wid * 32, qpos = qw0 + r32, NT = (q0 + 256) / 64;
    const float slope2 = exp2f(-2.f * (float)(h + 1)) * LOG2E;
    const bool isB = wid >= 4;
    const int krow = tid >> 3, kch = tid & 7, vrow = tid >> 4, vch = tid & 15;
    const int vlane = (4 * (lane >> 5) + ((lane & 15) >> 2)) * VSTRD + (16 * ((lane >> 4) & 1) + 4 * (lane & 3)) * 2;
    bf16* orow = mixo + (rowb + qpos) * D + h * 128 + 4 * hi;
    f32x16 o[4];
    for (int map = 0; map < 2; ++map) {
        const bf16* Qp = proj + (rowb + qpos) * NPROJ + C_DQ + h * 128 + map * 64;
        const bf16* Kb = proj + rowb * NPROJ + C_DK + h * 128 + map * 64 + (size_t)krow * NPROJ + kch * 8;
        const bf16* Vb = proj + rowb * NPROJ + C_DV + h * 128 + (size_t)vrow * NPROJ + vch * 8;
        bf16x8 qr[4];
#pragma unroll
        for (int d0 = 0; d0 < 4; ++d0) qr[d0] = *(const bf16x8*)(Qp + 16 * d0 + 8 * hi);
#pragma unroll
        for (int nb = 0; nb < 4; ++nb)
#pragma unroll
            for (int r = 0; r < 16; ++r) o[nb][r] = 0.f;
        float mref = 0.f, l = 0.f;
        u32x4 pwp[4]; bool havep = false; int pslot = 0;
#pragma unroll
        for (int k = 0; k < 4; ++k) pwp[k] = (u32x4){0u, 0u, 0u, 0u};
        u32x4 kreg = *(const u32x4*)(Kb), vreg0 = *(const u32x4*)(Vb), vreg1 = *(const u32x4*)(Vb + (size_t)32 * NPROJ);
        __syncthreads();
        *(LAS u32x4*)(lds + OFF_K + krow * KSTR + kch * 16) = kreg; *(LAS u32x4*)(lds + OFF_V + vrow * VSTRD + vch * 16) = vreg0; *(LAS u32x4*)(lds + OFF_V + (vrow + 32) * VSTRD + vch * 16) = vreg1;
        __syncthreads();
        int slot = 0;
        for (int t = 0; t < NT; ++t) {
            const int nslot = (slot == 2) ? 0 : slot + 1;
            if (t + 1 < NT) { const size_t go = (size_t)(64 * (t + 1)) * NPROJ; kreg = *(const u32x4*)(Kb + go); vreg0 = *(const u32x4*)(Vb + go); vreg1 = *(const u32x4*)(Vb + go + (size_t)32 * NPROJ); }
            if (isB && havep) { pv_packed<4, VSTRD>(o, lds + OFF_V + pslot * VBUFD + vlane, pwp); havep = false; }
            if (64 * t <= qw0) {
                f32x16 p0, p1;
                const int di = qpos - 64 * t - 4 * hi; const float bb = -slope2 * (float)di - mref;
#pragma unroll
                for (int r = 0; r < 16; ++r) { p0[r] = __builtin_fmaf(slope2, (float)CROW(r), bb); p1[r] = __builtin_fmaf(slope2, (float)(CROW(r) + 32), bb); }
                qk_tile(p0, p1, lds + OFF_K + slot * KBUF, qr, r32, hi);
                if (64 * t + 63 > qw0) {
#pragma unroll
                    for (int r = 0; r < 16; ++r) { p0[r] = (CROW(r) > di) ? -INFINITY : p0[r]; p1[r] = (CROW(r) + 32 > di) ? -INFINITY : p1[r]; } }
                float rm = fmaxf(p0[0], p1[0]);
#pragma unroll
                for (int r = 1; r < 16; ++r) rm = fmaxf(fmaxf(rm, p0[r]), p1[r]);
                rm = hmax(rm);
                if (__any(rm > 8.f)) {
                    const float dl = fmaxf(rm, 0.f), al = __builtin_amdgcn_exp2f(-dl); mref += dl; l *= al;
#pragma unroll
                    for (int r = 0; r < 16; ++r) { p0[r] -= dl; p1[r] -= dl; }
#pragma unroll
                    for (int nb = 0; nb < 4; ++nb)
#pragma unroll
                        for (int r = 0; r < 16; ++r) o[nb][r] *= al; }
                float ps = 0.f;
#pragma unroll
                for (int r = 0; r < 16; ++r) { p0[r] = __builtin_amdgcn_exp2f(p0[r]); p1[r] = __builtin_amdgcn_exp2f(p1[r]); ps += p0[r] + p1[r]; }
                l += ps;
                if (isB) { pack_p(pwp, p0, p1); havep = true; pslot = slot; }
                else { u32x4 pw[4]; pack_p(pw, p0, p1); pv_packed<4, VSTRD>(o, lds + OFF_V + slot * VBUFD + vlane, pw); }
            }
            if (t + 1 < NT) { *(LAS u32x4*)(lds + OFF_K + nslot * KBUF + krow * KSTR + kch * 16) = kreg;
                *(LAS u32x4*)(lds + OFF_V + nslot * VBUFD + vrow * VSTRD + vch * 16) = vreg0; *(LAS u32x4*)(lds + OFF_V + nslot * VBUFD + (vrow + 32) * VSTRD + vch * 16) = vreg1; }
            __syncthreads();
            slot = nslot;
        }
        if (isB && havep) pv_packed<4, VSTRD>(o, lds + OFF_V + pslot * VBUFD + vlane, pwp);
        const float lt = hsum(l);
        if (map == 0) { const float rl = 1.f / lt;
#pragma unroll
            for (int nb = 0; nb < 4; ++nb)
#pragma unroll
                for (int gq = 0; gq < 4; ++gq) { u32x2 w; w.x = cvtpk(o[nb][4 * gq] * rl, o[nb][4 * gq + 1] * rl); w.y = cvtpk(o[nb][4 * gq + 2] * rl, o[nb][4 * gq + 3] * rl);
                    *(u32x2*)(orow + 32 * nb + 8 * gq) = w; }
            asm volatile("s_waitcnt vmcnt(0)" ::: "memory");
        } else { const float rl2 = lam / lt; float ssq = 0.f;
#pragma unroll
            for (int nb = 0; nb < 4; ++nb)
#pragma unroll
                for (int gq = 0; gq < 4; ++gq) { const unsigned* sp = (const unsigned*)(orow + 32 * nb + 8 * gq);
                    const unsigned w0 = __hip_atomic_load(sp, __ATOMIC_RELAXED, __HIP_MEMORY_SCOPE_AGENT), w1 = __hip_atomic_load(sp + 1, __ATOMIC_RELAXED, __HIP_MEMORY_SCOPE_AGENT);
                    const float a0 = bflo(w0) - o[nb][4 * gq] * rl2, a1 = bfhi(w0) - o[nb][4 * gq + 1] * rl2, a2 = bflo(w1) - o[nb][4 * gq + 2] * rl2, a3 = bfhi(w1) - o[nb][4 * gq + 3] * rl2;
                    o[nb][4 * gq] = a0; o[nb][4 * gq + 1] = a1; o[nb][4 * gq + 2] = a2; o[nb][4 * gq + 3] = a3; ssq += (a0 * a0 + a1 * a1) + (a2 * a2 + a3 * a3); }
            ssq = hsum(ssq);
            const float inv = rsqrtf(ssq * (1.f / 128.f) + EPS) * 0.8f;
#pragma unroll
            for (int nb = 0; nb < 4; ++nb)
#pragma unroll
                for (int gq = 0; gq < 4; ++gq) { const int d = 32 * nb + 8 * gq; const f32x4 gv = *(const f32x4*)(g + d + 4 * hi);
                    u32x2 w; w.x = cvtpk(o[nb][4 * gq] * inv * gv[0], o[nb][4 * gq + 1] * inv * gv[1]); w.y = cvtpk(o[nb][4 * gq + 2] * inv * gv[2], o[nb][4 * gq + 3] * inv * gv[3]);
                    *(u32x2*)(orow + d) = w; }
        }
    }
}
__device__ __forceinline__ void sb_unit(LAS unsigned char* lds, const bf16* proj, bf16* mixo, int b, int h, int qb, const float* g) {
    const int tid = threadIdx.x, lane = tid & 63, r32 = lane & 31, hi = lane >> 5, wid = __builtin_amdgcn_readfirstlane(tid >> 6);
    const size_t rowb = (size_t)b * SEQ; const int q0 = qb * 256, qw0 = q0 + wid * 32, qpos = qw0 + r32, NT = (q0 + 256) / 64;
    const int krow = tid >> 3, kch = tid & 7;
    const int vlane = (4 * (lane >> 5) + ((lane & 15) >> 2)) * VSTRS + (16 * ((lane >> 4) & 1) + 4 * (lane & 3)) * 2;
    LAS int* cnt = (LAS int*)(lds + OFF_CNT);
    const bf16* Qp = proj + (rowb + qpos) * NPROJ + C_SQ + h * 64;
    const bf16* Kb = proj + rowb * NPROJ + C_SK + h * 64 + (size_t)krow * NPROJ + kch * 8;
    const bf16* Vb = proj + rowb * NPROJ + C_SV + h * 64 + (size_t)krow * NPROJ + kch * 8;
    bf16x8 qr[4];
#pragma unroll
    for (int d0 = 0; d0 < 4; ++d0) qr[d0] = *(const bf16x8*)(Qp + 16 * d0 + 8 * hi);
    f32x16 o[2];
#pragma unroll
    for (int nb = 0; nb < 2; ++nb)
#pragma unroll
        for (int r = 0; r < 16; ++r) o[nb][r] = 0.f;
    float R = 0.f; bool done = false;
    { const size_t go = (size_t)(64 * (NT - 1)) * NPROJ; u32x4 kreg = *(const u32x4*)(Kb + go), vreg = *(const u32x4*)(Vb + go);
      __syncthreads();
      if (tid < 32) cnt[tid] = 0;
      *(LAS u32x4*)(lds + OFF_K + krow * KSTR + kch * 16) = kreg; *(LAS u32x4*)(lds + OFF_V + krow * VSTRS + kch * 16) = vreg;
      __syncthreads(); }
    for (int it = 0; it < NT; ++it) {
        const int t = NT - 1 - it, buf = it & 1;
        u32x4 kreg, vreg;
        if (it + 1 < NT) { const size_t go = (size_t)(64 * (t - 1)) * NPROJ; kreg = *(const u32x4*)(Kb + go); vreg = *(const u32x4*)(Vb + go); }
        if (64 * t <= qw0 && !done) {
            f32x16 p0, p1, m0, m1;
#pragma unroll
            for (int r = 0; r < 16; ++r) { p0[r] = 0.f; p1[r] = 0.f; }
            qk_tile(p0, p1, lds + OFF_K + buf * KBUF, qr, r32, hi);
            const int di = qpos - 64 * t - 4 * hi;
#pragma unroll
            for (int r = 0; r < 16; ++r) {
                const float z0 = p0[r], z1 = p1[r];
                const float e0 = __builtin_amdgcn_exp2f(-fabsf(z0)), e1 = __builtin_amdgcn_exp2f(-fabsf(z1));
                const float ls0 = fminf(z0, 0.f) - __builtin_amdgcn_logf(1.f + e0), ls1 = fminf(z1, 0.f) - __builtin_amdgcn_logf(1.f + e1);
                p0[r] = ls0; p1[r] = ls1; m0[r] = ls0 - z0; m1[r] = ls1 - z1; }
            if (64 * t + 63 >= qw0) {
#pragma unroll
                for (int r = 0; r < 16; ++r) { const bool v0 = CROW(r) < di, v1 = CROW(r) + 32 < di;
                    p0[r] = v0 ? p0[r] : -INFINITY; p1[r] = v1 ? p1[r] : -INFINITY; m0[r] = v0 ? m0[r] : 0.f; m1[r] = v1 ? m1[r] : 0.f; } }
            float b0[4], b1[4], c0[4], c1[4];
#pragma unroll
            for (int gq = 0; gq < 4; ++gq) { const float s0 = (m0[4 * gq] + m0[4 * gq + 1]) + (m0[4 * gq + 2] + m0[4 * gq + 3]), s1 = (m1[4 * gq] + m1[4 * gq + 1]) + (m1[4 * gq + 2] + m1[4 * gq + 3]);
                c0[gq] = hsum(s0); c1[gq] = hsum(s1); b0[gq] = c0[gq] - s0; b1[gq] = c1[gq] - s1; }
            const float tot1 = (c1[0] + c1[1]) + (c1[2] + c1[3]), tot0 = (c0[0] + c0[1]) + (c0[2] + c0[3]);
            float S0[4], S1[4];
            S1[3] = R; S1[2] = S1[3] + c1[3]; S1[1] = S1[2] + c1[2]; S1[0] = S1[1] + c1[1];
            S0[3] = R + tot1; S0[2] = S0[3] + c0[3]; S0[1] = S0[2] + c0[2]; S0[0] = S0[1] + c0[1];
#pragma unroll
            for (int gq = 0; gq < 4; ++gq) {
                float l0 = S0[gq] + (hi == 0 ? b0[gq] : 0.f), l1 = S1[gq] + (hi == 0 ? b1[gq] : 0.f);
#pragma unroll
                for (int e = 3; e >= 0; --e) { const int r = 4 * gq + e;
                    const float w0 = __builtin_amdgcn_exp2f(p0[r] + l0), w1 = __builtin_amdgcn_exp2f(p1[r] + l1);
                    l0 += m0[r]; l1 += m1[r]; p0[r] = w0; p1[r] = w1; } }
            R += tot0 + tot1;
            { u32x4 pw[4]; pack_p(pw, p0, p1); pv_packed<2, VSTRS>(o, lds + OFF_V + buf * VBUFS + vlane, pw); }
            done = __all(R < -160.f);
        }
        if (done && lane == 0) (void)__hip_atomic_fetch_add(cnt + it, 1, __ATOMIC_RELAXED, __HIP_MEMORY_SCOPE_WORKGROUP);
        if (it + 1 < NT) { const int nb_ = buf ^ 1; *(LAS u32x4*)(lds + OFF_K + nb_ * KBUF + krow * KSTR + kch * 16) = kreg; *(LAS u32x4*)(lds + OFF_V + nb_ * VBUFS + krow * VSTRS + kch * 16) = vreg; }
        __syncthreads();
        if (__hip_atomic_load(cnt + it, __ATOMIC_RELAXED, __HIP_MEMORY_SCOPE_WORKGROUP) == 8) break;
    }
    float ssq = 0.f;
#pragma unroll
    for (int nb = 0; nb < 2; ++nb)
#pragma unroll
        for (int r = 0; r < 16; ++r) ssq += o[nb][r] * o[nb][r];
    ssq = hsum(ssq);
    const float inv = rsqrtf(ssq * (1.f / 64.f) + EPS);
    bf16* orow = mixo + (rowb + qpos) * D + 512 + h * 64 + 4 * hi;
#pragma unroll
    for (int nb = 0; nb < 2; ++nb)
#pragma unroll
        for (int gq = 0; gq < 4; ++gq) { const int d = 32 * nb + 8 * gq; const f32x4 gv = *(const f32x4*)(g + d + 4 * hi);
            u32x2 w; w.x = cvtpk(o[nb][4 * gq] * inv * gv[0], o[nb][4 * gq + 1] * inv * gv[1]); w.y = cvtpk(o[nb][4 * gq + 2] * inv * gv[2], o[nb][4 * gq + 3] * inv * gv[3]);
            *(u32x2*)(orow + d) = w; }
}
#undef CROW
}
#ifndef REP0
#define REP0 1
#endif
#ifndef REP1
#define REP1 1
#endif
#ifndef REP2D
#define REP2D 1
#endif
#ifndef REP2S
#define REP2S 1
#endif
#ifndef REP3
#define REP3 1
#endif
#ifndef REP5
#define REP5 1
#endif
#ifndef REP6
#define REP6 1
#endif
#ifndef REP4
#define REP4 1
#endif
typedef GAS unsigned gu32;
constexpr size_t WS_BAR = 768 * 1024;
constexpr int MISC_OFF = RING_BYTES + 320;
#define XB_TMO      128
#define XB_XCNT(j)  (256  + 64 * (j))
#define XB_XSUB(j)  (1280 + 64 * (j))
#define XB_XGEN(j)  (2304 + 64 * (j))
#define XB_TOP      3328
#define XB_TOPGEN   3392
#define XCD_BAR_WORDS 3456
#define XB_SPIN_CAP (1u << 18)

__device__ __forceinline__ unsigned xb_ld(unsigned* p)              { return __hip_atomic_load(p, __ATOMIC_RELAXED, __HIP_MEMORY_SCOPE_AGENT); }
__device__ __forceinline__ unsigned xb_add(unsigned* p, unsigned v) { return __hip_atomic_fetch_add(p, v, __ATOMIC_RELAXED, __HIP_MEMORY_SCOPE_AGENT); }
__device__ __forceinline__ unsigned xb_xcc_id() { return (unsigned)__builtin_amdgcn_s_getreg((3 << 11) | 20) & 0xFu; }
#define XB_SPIN(cond, bar) do { unsigned _sp = 0; while (cond) { __builtin_amdgcn_s_sleep(1); \
    if ((++_sp & 255u) == 0u) { if (xb_ld(&(bar)[XB_TMO])) break; if (_sp > XB_SPIN_CAP) { atomicAdd(&(bar)[XB_TMO], 1u); break; } } } } while (0)

struct XcdBarrier {
    unsigned* bar; unsigned x;
    volatile LAS unsigned* st;
};

__device__ __forceinline__ XcdBarrier xcd_barrier_post(unsigned* bar, volatile LAS unsigned* st) {
    XcdBarrier b; b.bar = bar; b.x = xb_xcc_id(); b.st = st;
    if (threadIdx.x == 0) (void)xb_add(&bar[XB_XCNT(b.x)], 1u);
    return b;
}
__device__ __forceinline__ void xcd_barrier_complete(unsigned* bar, unsigned x, unsigned& nloc, unsigned& nx) {
    const unsigned G = gridDim.x * gridDim.y * gridDim.z;
    unsigned sum, cnt, mine, sp = 0u;
    for (;;) {
        sum = 0u; cnt = 0u; mine = 0u;
#pragma unroll
        for (unsigned j = 0; j < 16; ++j) { const unsigned c = xb_ld(&bar[XB_XCNT(j)]); sum += c; cnt += (c > 0u) ? 1u : 0u; mine = (j == x) ? c : mine; }
        if (sum == G) break;
        __builtin_amdgcn_s_sleep(1);
        if ((++sp & 255u) == 0u) { if (xb_ld(&bar[XB_TMO])) break; if (sp > XB_SPIN_CAP) { atomicAdd(&bar[XB_TMO], 1u); break; } }
    }
    nloc = mine > 0u ? mine : 1u; nx = cnt > 0u ? cnt : 1u;
}

__device__ __forceinline__ void xcd_barrier(const XcdBarrier& b) {
    asm volatile("s_waitcnt vmcnt(0)" ::: "memory");
    __syncthreads();
    if (threadIdx.x == 0) {
        unsigned* bar = b.bar;
        __builtin_amdgcn_s_waitcnt(0);
        unsigned nloc = b.st[0], nx = b.st[1];
        if (nloc == 0u) { xcd_barrier_complete(bar, b.x, nloc, nx); b.st[0] = nloc; b.st[1] = nx; }
        const unsigned old = xb_add(&bar[XB_XSUB(b.x)], 1u);
        const unsigned gen = old / nloc;
        if (old + 1u == (gen + 1u) * nloc) {
            __builtin_amdgcn_fence(__ATOMIC_RELEASE, "agent");
            asm volatile("s_waitcnt vmcnt(0)" ::: "memory");
            const unsigned og = xb_add(&bar[XB_TOP], 1u);
            const unsigned tg = og / nx;
            if (og + 1u == (tg + 1u) * nx) xb_add(&bar[XB_TOPGEN], 1u);
            else XB_SPIN(xb_ld(&bar[XB_TOPGEN]) == tg, bar);
            __builtin_amdgcn_fence(__ATOMIC_ACQUIRE, "agent");
            xb_add(&bar[XB_XGEN(b.x)], 1u);
            asm volatile("s_waitcnt vmcnt(0)" ::: "memory");
        } else {
            XB_SPIN(xb_ld(&bar[XB_XGEN(b.x)]) == gen, bar);
            __builtin_amdgcn_fence(__ATOMIC_ACQUIRE, "agent");
            asm volatile("s_waitcnt vmcnt(0)" ::: "memory");
        }
    }
    __syncthreads();
}

__global__ void __launch_bounds__(NWAVES * 64, 2) fwd(Args args) {
    extern __shared__ __attribute__((aligned(16))) unsigned char lds[];
    Frame F;
    F.lds = (LAS unsigned char*)lds;
    F.tid = threadIdx.x; F.lane = F.tid & 63; F.wave = __builtin_amdgcn_readfirstlane(F.tid >> 6);
    F.G = gridDim.x; { const int bx = blockIdx.x; F.vcu = (F.G % 8 == 0) ? (bx % 8) * (F.G / 8) + bx / 8 : bx; }
    unsigned char* ws = args.ws;
    const int lo = args.ph_lo, hi = args.ph_hi;
    for (int u = F.tid; u < (LDS_BYTES - RING_BYTES) / 4; u += NWAVES * 64) ((LAS unsigned*)(F.lds + RING_BYTES))[u] = 0u;
    __syncthreads();
    if (args.coop == 2) cg::this_grid().sync();
    XcdBarrier bar = xcd_barrier_post((unsigned*)(ws + WS_BAR), (volatile LAS unsigned*)(F.lds + MISC_OFF) + 8);
#define IN(k) (lo <= (k) && (k) < hi)
#define SEAM(k) do { if (IN(k) && IN((k) + 1)) { xcd_barrier(bar); } } while (0)
    if (IN(0)) { for (int rep = 0; rep < REP0; ++rep) p0_prologue(F, args); } SEAM(0);
    if (IN(1)) for (int rep = 0; rep < REP1; ++rep) {
        pg8::Gemm g{(const bf16*)(ws + WS_XN), (const bf16*)(ws + WS_WQKV), M, NPROJ, D}; pg8::StaticOrder S; S.init(M, NPROJ, F.G, (int)blockIdx.x);
        pg8::EpiBf16Plain E{(bf16*)(ws + WS_PROJ), NPROJ, 0.125f * 1.4426950408889634f};
        pg8::gemm_phase<pg8::EpiBf16Plain, pg8::StaticOrder, PG8_ALIGN, PG8_SP2>(F.lds + RING_OFF, g, S, E);
    } SEAM(1);
    if (IN(2)) {
        const float lam = lam_of(args.in[3], args.in[4], args.in[5], args.in[6]);
        const bf16* proj = (const bf16*)(ws + WS_PROJ); bf16* mixo = (bf16*)(ws + WS_MIX);
        for (int pr_ = F.vcu; pr_ < BATCH * 4 * 4 * REP2D; pr_ += F.G) { const int pr = pr_ & (BATCH * 4 * 4 - 1), bh = pr >> 2, s = pr & 3;
            for (int k = 0; k < 2; ++k) mixer::diff_unit(F.lds, proj, mixo, bh >> 2, bh & 3, k ? s : 7 - s, lam, args.in[7]); }
        for (int u_ = F.vcu; u_ < BATCH * 8 * 8 * REP2S; u_ += F.G) { const int u = u_ & (BATCH * 8 * 8 - 1), bh = u >> 3, qb = (u + (u >> 8) * 3) & 7;
            mixer::sb_unit(F.lds, proj, mixo, bh >> 3, bh & 7, qb, args.in[8]); }
    }
    SEAM(2);
    if (IN(3) && REP3 > 1) {
        pg8::Gemm g{(const bf16*)(ws + WS_MIX), (const bf16*)(ws + WS_WO), M, D, D}; pg8::StaticOrder S; S.init(M, D, F.G, (int)blockIdx.x);
        pg8::EpiResidB<true> E{args.in[0], (bf16*)(ws + WS_PROJ), (float*)(ws + 512 * 1024), D};
        pg8::gemm_phase<pg8::EpiResidB<true>, pg8::StaticOrder, PG8_ALIGN, PG8_SP2>(F.lds + RING_OFF, g, S, E);
    }
    if (IN(3)) {
        pg8::Gemm g{(const bf16*)(ws + WS_MIX), (const bf16*)(ws + WS_WO), M, D, D}; pg8::StaticOrder S; S.init(M, D, F.G, (int)blockIdx.x);
        pg8::EpiResidB<true> E{args.in[0], (bf16*)(ws + WS_XN), (float*)(ws + WS_SS1), D};
        pg8::gemm_phase<pg8::EpiResidB<true>, pg8::StaticOrder, PG8_ALIGN, PG8_SP2>(F.lds + RING_OFF, g, S, E);
    } SEAM(3);
    if (IN(4)) for (int rep = 0; rep < REP4; ++rep) {
        pg8::Gemm g{(const bf16*)(ws + WS_XN), (const bf16*)(ws + WS_W1), M, FF, D}; pg8::StaticOrder S; S.init(M, FF, F.G, (int)blockIdx.x);
        pg8::EpiSqRelu E{(bf16*)(ws + WS_U), FF, (const float*)(ws + WS_SS1)};
        pg8::gemm_phase<pg8::EpiSqRelu, pg8::StaticOrder, PG8_ALIGN, PG8_SP2>(F.lds + RING_OFF, g, S, E);
    } SEAM(4);
    if (IN(5) && REP5 > 1) {
        pg8::Gemm g{(const bf16*)(ws + WS_U), (const bf16*)(ws + WS_W2), M, D, FF}; pg8::StaticOrder S; S.init(M, D, F.G, (int)blockIdx.x);
        pg8::EpiResidB<false> E{(const bf16*)(ws + WS_XN), (bf16*)(ws + 352 * MiB), (float*)(ws + 512 * 1024), D};
        pg8::gemm_phase<pg8::EpiResidB<false>, pg8::StaticOrder, PG8_ALIGN, PG8_SP2>(F.lds + RING_OFF, g, S, E);
    }
    if (IN(5)) {
        pg8::Gemm g{(const bf16*)(ws + WS_U), (const bf16*)(ws + WS_W2), M, D, FF}; pg8::StaticOrder S; S.init(M, D, F.G, (int)blockIdx.x);
        pg8::EpiResidB<false> E{(const bf16*)(ws + WS_XN), (bf16*)(ws + WS_XN), (float*)(ws + WS_SS2), D};
        pg8::gemm_phase<pg8::EpiResidB<false>, pg8::StaticOrder, PG8_ALIGN, PG8_SP2>(F.lds + RING_OFF, g, S, E);
    } SEAM(5);
    if (IN(6) && REP6 > 1) { p6_final(F, args, (float*)(ws + 352 * MiB)); }
    if (IN(6)) { p6_final(F, args, args.out); }
#undef IN
#undef SEAM
}

extern "C" void kernel_launch(void* const* d_in, const int* in_sizes, int n_in, void* d_out, int out_size, void* d_ws, size_t ws_size, hipStream_t stream) {
    static int grid = 0;
    if (grid == 0) {
        if (n_in != 14 || in_sizes[0] != M * D || out_size != M * D || ws_size < WS_END) { fprintf(stderr, "kernel_launch: unexpected shapes (n_in %d, in0 %d, out %d, ws %zu)\n", n_in, n_in > 0 ? in_sizes[0] : -1, out_size, ws_size); grid = -1; return; }
        int dev = 0, cus = 0;
        if (hipGetDevice(&dev) != hipSuccess || hipDeviceGetAttribute(&cus, hipDeviceAttributeMultiprocessorCount, dev) != hipSuccess) { grid = -1; return; }
        if (hipFuncSetAttribute((const void*)fwd, hipFuncAttributeMaxDynamicSharedMemorySize, LDS_BYTES) != hipSuccess) { fprintf(stderr, "kernel_launch: hipFuncSetAttribute failed\n"); grid = -1; return; }
        grid = cus;
    }
    if (grid < 0) return;
    (void)hipMemsetAsync((char*)d_ws + WS_CTL, 0, CTL_ZERO_BYTES, stream);
    Args a{};
    for (int i = 0; i < 14; ++i) a.in[i] = (const float*)d_in[i];
    a.out = (float*)d_out; a.ws = (unsigned char*)d_ws; a.coop = 0; a.pad = 0;
    unsigned char* ws = (unsigned char*)d_ws;
    a.ph_lo = 0; a.ph_hi = 7; a.coop = 1;
    void* kargs[] = {&a};
    hipError_t e = hipLaunchCooperativeKernel((const void*)fwd, dim3(grid), dim3(NWAVES * 64), kargs, LDS_BYTES, stream);
    if (e != hipSuccess) fprintf(stderr, "kernel_launch: cooperative launch failed: %s (grid %d)\n", hipGetErrorString(e), grid);
}
```
